# Optimizing an MI355X kernel written in HIP

```python
import jax, jax.numpy as jnp
from jax import lax
import numpy as np

D_MODEL = 1024
BATCH = 4
SEQ = 8192
DEPTH = 4

GRID_W = 64
CTX_LEN = 256
D_MIX = D_MODEL
D_CONV = D_MIX // 2
D_ATTN = D_MIX - D_CONV
HEAD_DIM = 64
N_HEADS = D_ATTN // HEAD_DIM
N_KV = 2
GQA = N_HEADS // N_KV
CONV_WIDTH = 3
WINDOW = 128
BLOCK = 128
ROPE_THETA = 10000.0
D_FF = 2816
N_EXPERTS = 8
TOP_K = 2
D_FF_EXPERT = 1408
N_DENSE = (DEPTH + 1) // 2
N_MOE = DEPTH // 2
EPS = 1e-6
KV_OFF = 3 * D_CONV + D_ATTN
D_IN = KV_OFF + 2 * N_KV * HEAD_DIM
SPLITS = (D_CONV, 2 * D_CONV, 3 * D_CONV, KV_OFF, KV_OFF + N_KV * HEAD_DIM)

kernel_name = "hybrid_conv_swa_moe_dit_block"


def rmsnorm(x, g):
    xf = x.astype(jnp.float32)
    y = xf * lax.rsqrt(jnp.mean(xf * xf, axis=-1, keepdims=True) + EPS)
    return (y * g.astype(jnp.float32)).astype(x.dtype)


def modulate(x, shift, scale):
    return x * (1 + scale) + shift


def axial_rope_tables(rows):
    row, col = jnp.meshgrid(jnp.arange(rows, dtype=jnp.float32),
                            jnp.arange(GRID_W, dtype=jnp.float32), indexing='ij')
    n_freq = HEAD_DIM // 4
    inv_freq = ROPE_THETA ** (-jnp.arange(n_freq, dtype=jnp.float32) / n_freq)
    ang_r = row.reshape(-1, 1) * inv_freq
    ang_c = col.reshape(-1, 1) * inv_freq
    ang = jnp.concatenate([ang_r, ang_r, ang_c, ang_c], axis=-1)
    return jnp.cos(ang)[None, :, None, :], jnp.sin(ang)[None, :, None, :]


def apply_axial_rope(t, cos, sin):
    tf = t.astype(jnp.float32)
    tr = tf.reshape(t.shape[:-1] + (2, 2, HEAD_DIM // 4))
    rot = jnp.stack([-tr[..., 1, :], tr[..., 0, :]], axis=-2).reshape(t.shape)
    return (tf * cos + rot * sin).astype(t.dtype)


def split_heads_kv(zkv, k_g):
    B, L = zkv.shape[:2]
    k, v = jnp.split(zkv, 2, axis=-1)
    k = rmsnorm(k.reshape(B, L, N_KV, HEAD_DIM), k_g)
    return k, v.reshape(B, L, N_KV, HEAD_DIM)


def mixer_inputs(xn, w_in, q_g, k_g):
    B, L = xn.shape[:2]
    bg, cg, hu, q, k, v = jnp.split(xn @ w_in, SPLITS, axis=-1)
    q = rmsnorm(q.reshape(B, L, N_HEADS, HEAD_DIM), q_g)
    k = rmsnorm(k.reshape(B, L, N_KV, HEAD_DIM), k_g)
    return bg, cg, hu, q, k, v.reshape(B, L, N_KV, HEAD_DIM)


def short_gated_conv(bg, cg, hu, conv_w):
    u = cg * hu
    y = lax.conv_general_dilated(u, conv_w[:, None, :].astype(u.dtype), window_strides=(1,),
                                 padding='SAME', dimension_numbers=('NWC', 'WIO', 'NWC'),
                                 feature_group_count=u.shape[-1])
    return bg * y


def window_attention(q, k, v, kc, vc, sink):
    B, S = q.shape[:2]
    nb = S // BLOCK
    scale = HEAD_DIM ** -0.5
    f32 = jnp.float32
    qb = q.astype(f32).reshape(B, nb, BLOCK, N_KV, GQA, HEAD_DIM)
    pad = ((0, 0), (BLOCK, BLOCK), (0, 0), (0, 0))
    kp = jnp.pad(k.astype(f32), pad)
    vp = jnp.pad(v.astype(f32), pad)

    def bands(t):
        return jnp.concatenate(
            [t[:, o:o + S].reshape(B, nb, BLOCK, N_KV, HEAD_DIM) for o in (0, BLOCK, 2 * BLOCK)], axis=2)

    kb, vb = bands(kp), bands(vp)
    kcf, vcf = kc.astype(f32), vc.astype(f32)
    s_win = jnp.einsum('bnqgrd,bnkgd->bngrqk', qb, kb) * scale
    qi = jnp.arange(BLOCK)[:, None]
    kj = jnp.arange(3 * BLOCK)[None, :]
    key_pos = jnp.arange(nb)[:, None, None] * BLOCK + kj[None] - BLOCK
    valid = (jnp.abs(kj - BLOCK - qi) <= WINDOW)[None] & (key_pos >= 0) & (key_pos < S)
    s_win = jnp.where(valid[None, :, None, None], s_win, -jnp.inf)
    s_ctx = jnp.einsum('bnqgrd,blgd->bngrql', qb, kcf) * scale
    sk = sink.astype(f32).reshape(1, 1, N_KV, GQA, 1, 1)
    m = jnp.maximum(jnp.maximum(s_win.max(-1, keepdims=True), s_ctx.max(-1, keepdims=True)), sk)
    p_win = jnp.exp(s_win - m)
    p_ctx = jnp.exp(s_ctx - m)
    denom = jnp.exp(sk - m) + p_win.sum(-1, keepdims=True) + p_ctx.sum(-1, keepdims=True)
    o = (jnp.einsum('bngrqk,bnkgd->bnqgrd', p_win, vb)
         + jnp.einsum('bngrql,blgd->bnqgrd', p_ctx, vcf))
    o = o / jnp.moveaxis(denom, 4, 2)
    return o.reshape(B, S, D_ATTN).astype(q.dtype)


def context_attention(qc, kc, vc, sink):
    B, L = qc.shape[:2]
    f32 = jnp.float32
    q = qc.astype(f32).reshape(B, L, N_KV, GQA, HEAD_DIM)
    s = jnp.einsum('blgrd,bmgd->bgrlm', q, kc.astype(f32)) * (HEAD_DIM ** -0.5)
    sk = jnp.broadcast_to(sink.astype(f32).reshape(1, N_KV, GQA, 1, 1), s.shape[:-1] + (1,))
    p = jax.nn.softmax(jnp.concatenate([sk, s], axis=-1), axis=-1)[..., 1:]
    o = jnp.einsum('bgrlm,bmgd->blgrd', p, vc.astype(f32))
    return o.reshape(B, L, D_ATTN).astype(qc.dtype)


def merge_groups(y_conv, y_attn, g_conv, g_attn, w_out):
    return jnp.concatenate([rmsnorm(y_conv, g_conv), rmsnorm(y_attn, g_attn)], axis=-1) @ w_out


def swiglu(x, w1, w3, w2):
    return (jax.nn.silu(x @ w1) * (x @ w3)) @ w2


def moe_swiglu(x, router, w1, w3, w2):
    logits = (x @ router).astype(jnp.float32)
    top_v, top_i = lax.top_k(logits, TOP_K)
    gates = jax.nn.softmax(top_v, axis=-1)
    combine = jnp.sum(jax.nn.one_hot(top_i, N_EXPERTS, dtype=jnp.float32) * gates[..., None], axis=-2)
    combine = combine.astype(x.dtype)
    out = jnp.zeros_like(x)
    for e in range(N_EXPERTS):
        out = out + combine[..., e:e + 1] * swiglu(x, w1[e], w3[e], w2[e])
    return out


def channel_mixer(layer, xn, ffn_w1, ffn_w3, ffn_w2, moe_router, moe_w1, moe_w3, moe_w2):
    i = layer // 2
    if layer % 2 == 0:
        return swiglu(xn, ffn_w1[i], ffn_w3[i], ffn_w2[i])
    return moe_swiglu(xn, moe_router[i], moe_w1[i], moe_w3[i], moe_w2[i])


def setup_inputs(seed: int = 0) -> dict:
    key = jax.random.key(seed)
    ks = jax.random.split(key, 24)
    n = jax.random.normal
    f32 = jnp.float32
    D = D_MODEL
    return {
        "x": n(ks[0], (BATCH, SEQ, D), f32),
        "c": n(ks[1], (BATCH, D), f32),
        "ctx": n(ks[2], (BATCH, CTX_LEN, D), f32),
        "c_ctx": n(ks[3], (D,), f32),
        "w_ada": n(ks[4], (DEPTH, D, 6 * D), f32) * (0.5 * D ** -0.5),
        "b_ada": n(ks[5], (DEPTH, 6 * D), f32) * 0.01,
        "norm1_g": 1.0 + 0.02 * n(ks[6], (DEPTH, D), f32),
        "norm2_g": 1.0 + 0.02 * n(ks[7], (DEPTH, D), f32),
        "w_in": n(ks[8], (DEPTH, D, D_IN), f32) * D ** -0.5,
        "conv_w": n(ks[9], (DEPTH, CONV_WIDTH, D_CONV), f32) * CONV_WIDTH ** -0.5,
        "q_norm_g": 1.0 + 0.02 * n(ks[10], (DEPTH, HEAD_DIM), f32),
        "k_norm_g": 1.0 + 0.02 * n(ks[11], (DEPTH, HEAD_DIM), f32),
        "attn_sink": 0.5 * n(ks[12], (DEPTH, N_HEADS), f32),
        "out_norm_conv_g": 1.0 + 0.02 * n(ks[13], (DEPTH, D_CONV), f32),
        "out_norm_attn_g": 1.0 + 0.02 * n(ks[14], (DEPTH, D_ATTN), f32),
        "w_out": n(ks[15], (DEPTH, D_MIX, D), f32) * D_MIX ** -0.5,
        "ffn_w1": n(ks[16], (N_DENSE, D, D_FF), f32) * D ** -0.5,
        "ffn_w3": n(ks[17], (N_DENSE, D, D_FF), f32) * D ** -0.5,
        "ffn_w2": n(ks[18], (N_DENSE, D_FF, D), f32) * D_FF ** -0.5,
        "moe_router": n(ks[19], (N_MOE, D, N_EXPERTS), f32) * D ** -0.5,
        "moe_w1": n(ks[20], (N_MOE, N_EXPERTS, D, D_FF_EXPERT), f32) * D ** -0.5,
        "moe_w3": n(ks[21], (N_MOE, N_EXPERTS, D, D_FF_EXPERT), f32) * D ** -0.5,
        "moe_w2": n(ks[22], (N_MOE, N_EXPERTS, D_FF_EXPERT, D), f32) * D_FF_EXPERT ** -0.5,
    }


def reference(x, c, ctx, c_ctx, w_ada, b_ada, norm1_g, norm2_g, w_in, conv_w, q_norm_g, k_norm_g,
              attn_sink, out_norm_conv_g, out_norm_attn_g, w_out, ffn_w1, ffn_w3, ffn_w2,
              moe_router, moe_w1, moe_w3, moe_w2):
    B, S, D = x.shape
    ROWS = S // GRID_W
    cos, sin = axial_rope_tables(ROWS)
    sc = jax.nn.silu(c)[:, None, :]
    scc = jax.nn.silu(c_ctx)[None, None, :]
    h, hc = x, ctx
    for layer in range(DEPTH):
        last = layer == DEPTH - 1
        sh1, sc1, g1, sh2, sc2, g2 = jnp.split(sc @ w_ada[layer] + b_ada[layer], 6, axis=-1)
        n_mod_c = 2 if last else 6
        mod_c = jnp.split(scc @ w_ada[layer][:, :n_mod_c * D] + b_ada[layer][:n_mod_c * D], n_mod_c, axis=-1)

        xn = modulate(rmsnorm(h, norm1_g[layer]), sh1, sc1)
        xnc = modulate(rmsnorm(hc, norm1_g[layer]), mod_c[0], mod_c[1])
        bg, cg, hu, q, k, v = mixer_inputs(xn, w_in[layer], q_norm_g[layer], k_norm_g[layer])
        q = apply_axial_rope(q, cos, sin)
        k = apply_axial_rope(k, cos, sin)
        if last:
            kc, vc = split_heads_kv(xnc @ w_in[layer][:, KV_OFF:], k_norm_g[layer])
        else:
            bgc, cgc, huc, qc, kc, vc = mixer_inputs(xnc, w_in[layer], q_norm_g[layer], k_norm_g[layer])
        y_conv = short_gated_conv(bg, cg, hu, conv_w[layer])
        y_attn = window_attention(q, k, v, kc, vc, attn_sink[layer])
        y = merge_groups(y_conv, y_attn, out_norm_conv_g[layer], out_norm_attn_g[layer], w_out[layer])
        h = h + g1 * y
        if not last:
            yc_conv = short_gated_conv(bgc, cgc, huc, conv_w[layer])
            yc_attn = context_attention(qc, kc, vc, attn_sink[layer])
            yc = merge_groups(yc_conv, yc_attn, out_norm_conv_g[layer], out_norm_attn_g[layer], w_out[layer])
            hc = hc + mod_c[2] * yc

        xn2 = modulate(rmsnorm(h, norm2_g[layer]), sh2, sc2)
        h = h + g2 * channel_mixer(layer, xn2, ffn_w1, ffn_w3, ffn_w2, moe_router, moe_w1, moe_w3, moe_w2)
        if not last:
            xnc2 = modulate(rmsnorm(hc, norm2_g[layer]), mod_c[3], mod_c[4])
            hc = hc + mod_c[5] * channel_mixer(layer, xnc2, ffn_w1, ffn_w3, ffn_w2,
                                               moe_router, moe_w1, moe_w3, moe_w2)
    return h
```

```cpp
#include <hip/hip_runtime.h>
#include <cstdio>
#include <cstdint>
#ifndef MK_SINGLE
#define MK_SINGLE 1
#endif
namespace pg8 {
#define PG8_LAS __attribute__((address_space(3)))
typedef unsigned short bf16_t;
typedef short bf16x8 __attribute__((ext_vector_type(8)));
typedef float f32x4 __attribute__((ext_vector_type(4)));
typedef unsigned u32x4 __attribute__((ext_vector_type(4)));
constexpr int BM = 256, BK = 64, HALF = 128, HTB = HALF * BK * 2  , STAGE_BYTES = 8 * HTB, NXCD = 8, WGM = 8;

__host__ __device__ __forceinline__ int lds_byte(int r, int c) { const int st = (r >> 4) * 2 + (c >> 5), rr = r & 15, cc = c & 31, ob = rr * 64 + cc * 2; return st * 1024 + (ob ^ (((ob >> 9) & 1) << 5)); }
__host__ __device__ __forceinline__ void stage_rc(int b, int& R, int& C) { const int st = b / 1024, sb = b % 1024, swz = sb ^ (((sb >> 9) & 1) << 5); R = (st >> 1) * 16 + swz / 64; C = (st & 1) * 32 + (swz % 64) / 2; }
__host__ __device__ __forceinline__ int perm32(int rho) { const int n = rho >> 4, i = rho & 15; return 8 * (i >> 2) + 4 * n + (i & 3); }

struct Unit { int pm, pn, kofs, ks, hm; };
struct Gemm { const bf16_t* A; const bf16_t* Bt; int K; int ld; const int* tok; };

struct Sched {
    static constexpr bool TAIL = false;
    int nM, nN, nwg, G, c, moe, split, kp2; int ps[8];
    __device__ __forceinline__ void init(int nM_, int nN_, int G_, int c_) { nM = nM_; nN = nN_; nwg = nM * nN; G = G_; c = c_; moe = 0; split = 0; kp2 = 0;
#pragma unroll
        for (int j = 0; j < 8; ++j) ps[j] = 0; }
    __device__ __forceinline__ bool next(int i, Unit& u) const {
        const long L = (long)i * G + c; if (L >= nwg) return false;
        u.hm = 15;
        if (split) { const int ks = (int)L % split, t = (int)L / split; u.pm = 128 + t / nN; u.pn = t % nN; u.ks = ks; u.kofs = ks * kp2; return true; }
        int wgid = (int)L; { const int q = nwg / NXCD, r = nwg % NXCD, xcd = wgid % NXCD, off = wgid / NXCD; wgid = (xcd < r ? xcd * (q + 1) : r * (q + 1) + (xcd - r) * q) + off; }
        const int nig = WGM * nN, gid = wgid / nig, fm = gid * WGM, gsz = (nM - fm) < WGM ? (nM - fm) : WGM;
        const int pm = fm + ((wgid % nig) % gsz), n = (wgid % nig) / gsz;
        int e = 0;
        if (moe) {
#pragma unroll
            for (int j = 1; j < 8; ++j) e += (pm >= ps[j]) ? 1 : 0; }
        u.pm = pm; u.pn = e * nN + n; u.kofs = 0; u.ks = 0; return true;
    }
    __device__ __forceinline__ void a_ready(const Unit&) const {}
    __device__ __forceinline__ void done(const Unit&) const {}
};

struct SchedT : Sched {
    static constexpr bool TAIL = true;
    int nfull, npiece, tsplit;
    __device__ __forceinline__ bool next(int i, Unit& u) const {
        if (i > 0 || c >= npiece) return false;
        const int wgid = nfull + c / tsplit, q = c % tsplit;
        const int nig = WGM * nN, gid = wgid / nig, fm = gid * WGM, gsz = (nM - fm) < WGM ? (nM - fm) : WGM;
        const int pm = fm + ((wgid % nig) % gsz), n = (wgid % nig) / gsz;
        int e = 0;
        if (moe) {
#pragma unroll
            for (int j = 1; j < 8; ++j) e += (pm >= ps[j]) ? 1 : 0; }
        u.pm = pm; u.pn = e * nN + n; u.kofs = 0; u.ks = 0; u.hm = (tsplit == 4) ? (1 << q) : (q ? 12 : 3); return true;
    }
};
__device__ __forceinline__ unsigned cvt_pk_bf16(float lo, float hi) { unsigned r; asm volatile("v_cvt_pk_bf16_f32 %0, %1, %2" : "=v"(r) : "v"(lo), "v"(hi)); return r; }

struct EpiStoreBf16 {
    static constexpr bool PERM = true, AFTER_DRAIN = false;
    bf16_t* O; int ldc; int ntn;
    __device__ __forceinline__ void operator()(const f32x4 (&acc)[2][2][4][2], const Unit& u, int wr, int wc, int fr, int fq) const {
        const int row0 = u.pm * BM + wr * 64 + fr; const int col0 = (u.pn % ntn) * BM + wc * 32 + 8 * fq;
#pragma unroll
        for (int ai = 0; ai < 2; ++ai)
#pragma unroll
            for (int m = 0; m < 4; ++m) { bf16_t* rowp = O + (size_t)(row0 + ai * HALF + m * 16) * ldc + col0;
#pragma unroll
                for (int bj = 0; bj < 2; ++bj) { const f32x4 v0 = acc[ai][bj][m][0], v1 = acc[ai][bj][m][1];
                    u32x4 w; w.x = cvt_pk_bf16(v0[0], v0[1]); w.y = cvt_pk_bf16(v0[2], v0[3]); w.z = cvt_pk_bf16(v1[0], v1[1]); w.w = cvt_pk_bf16(v1[2], v1[3]);
                    *(u32x4*)(rowp + bj * HALF) = w; } }
    }
};
struct EpiIn {
    static constexpr bool PERM = true, AFTER_DRAIN = false;
    bf16_t* O; const float* qg; const float* kg; const float* rope; float qscale; float eps;
    __device__ __forceinline__ void operator()(const f32x4 (&acc)[2][2][4][2], const Unit& u, int wr, int wc, int fr_in, int fq_in) const {
        (void)fr_in; (void)fq_in; int t_ = threadIdx.x; asm volatile("" : "+v"(t_)); const int fr = t_ & 15, fq = (t_ >> 4) & 3;
        const int row0 = u.pm * BM + wr * 64 + fr; const int col0 = u.pn * BM + wc * 32 + 8 * fq; constexpr int ldc = 2304;
        const bool isq = (u.pn == 6 || u.pn == 7), isk = (u.pn == 8 && wc < 2);
        if (u.pn >= 2 && u.pn <= 5) {
            const int cu0 = 512 + (u.pn - 2) * HALF + wc * 32 + 8 * fq;
#pragma unroll
            for (int ai = 0; ai < 2; ++ai)
#pragma unroll
                for (int m = 0; m < 4; ++m) { const f32x4 a0 = acc[ai][0][m][0] * acc[ai][1][m][0], a1 = acc[ai][0][m][1] * acc[ai][1][m][1];
                    u32x4 w; w.x = cvt_pk_bf16(a0[0], a0[1]); w.y = cvt_pk_bf16(a0[2], a0[3]); w.z = cvt_pk_bf16(a1[0], a1[1]); w.w = cvt_pk_bf16(a1[2], a1[3]);
                    *(u32x4*)(O + (size_t)(row0 + ai * HALF + m * 16) * ldc + cu0) = w; }
            return;
        }
        if (!(isq || isk)) {
#pragma unroll
            for (int ai = 0; ai < 2; ++ai)
#pragma unroll
                for (int m = 0; m < 4; ++m) { bf16_t* rowp = O + (size_t)(row0 + ai * HALF + m * 16) * ldc + col0;
#pragma unroll
                    for (int bj = 0; bj < 2; ++bj) { const f32x4 v0 = acc[ai][bj][m][0], v1 = acc[ai][bj][m][1];
                        u32x4 w; w.x = cvt_pk_bf16(v0[0], v0[1]); w.y = cvt_pk_bf16(v0[2], v0[3]); w.z = cvt_pk_bf16(v1[0], v1[1]); w.w = cvt_pk_bf16(v1[2], v1[3]);
                        *(u32x4*)(rowp + bj * HALF) = w; } }
            return;
        }
        const float* gp = isq ? qg : kg; const float sc = isq ? qscale : 1.0f; const bool lat = u.pm < 128;
        f32x4 gn[2][2];
#pragma unroll
        for (int bj = 0; bj < 2; ++bj)
#pragma unroll
            for (int n = 0; n < 2; ++n) gn[bj][n] = *(const f32x4*)(gp + 32 * bj + 16 * n + 4 * fq) * sc;
        u32x4 w[4][2];
        f32x4 rn[2][2] = {};
        const int ln = fq * 16 + fr;
#define EPIIN_ROPE(g, r) do { const int t_ = (row0 + ((g) >> 2) * HALF + ((g) & 3) * 16) & 8191; _Pragma("unroll") for (int bj = 0; bj < 2; ++bj) { const int pos_ = bj ? (t_ & 63) : (t_ >> 6); \
            const float* p_ = rope + (size_t)(pos_ * 16 + 4 * fq) * 2; r[bj][0] = *(const f32x4*)p_; r[bj][1] = *(const f32x4*)(p_ + 4); } } while (0)
        if (lat) EPIIN_ROPE(0, rn);
#pragma unroll
        for (int ai = 0; ai < 2; ++ai) {
            float rinv[4];
#pragma unroll
            for (int m = 0; m < 4; ++m) { float ss = 0.f;
#pragma unroll
                for (int bj = 0; bj < 2; ++bj)
#pragma unroll
                    for (int n = 0; n < 2; ++n) { const f32x4 x = acc[ai][bj][m][n]; ss += (x[0] * x[0] + x[1] * x[1]) + (x[2] * x[2] + x[3] * x[3]); }
                rinv[m] = ss; }
#pragma unroll
            for (int m = 0; m < 4; ++m) rinv[m] += __int_as_float(__builtin_amdgcn_ds_bpermute((ln ^ 16) << 2, __float_as_int(rinv[m])));
#pragma unroll
            for (int m = 0; m < 4; ++m) rinv[m] += __int_as_float(__builtin_amdgcn_ds_bpermute((ln ^ 32) << 2, __float_as_int(rinv[m])));
#pragma unroll
            for (int m = 0; m < 4; ++m) rinv[m] = __builtin_amdgcn_rsqf(rinv[m] * (1.0f / 64.0f) + eps);
#pragma unroll
            for (int m = 0; m < 4; ++m) { const int g = ai * 4 + m;
                f32x4 rc[2][2];
#pragma unroll
                for (int bj = 0; bj < 2; ++bj) { rc[bj][0] = rn[bj][0]; rc[bj][1] = rn[bj][1]; }
                if (lat && g < 7) EPIIN_ROPE(g + 1, rn);
#pragma unroll
                for (int bj = 0; bj < 2; ++bj) { f32x4 y0 = acc[ai][bj][m][0] * rinv[m] * gn[bj][0], y1 = acc[ai][bj][m][1] * rinv[m] * gn[bj][1];
                    if (lat) { const f32x4 ca = rc[bj][0], cb = rc[bj][1];
                        const f32x4 c = {ca[0], ca[2], cb[0], cb[2]}, sn = {ca[1], ca[3], cb[1], cb[3]};
                        const f32x4 o0 = y0 * c - y1 * sn, o1 = y1 * c + y0 * sn; y0 = o0; y1 = o1; }
                    w[m][bj].x = cvt_pk_bf16(y0[0], y0[1]); w[m][bj].y = cvt_pk_bf16(y0[2], y0[3]); w[m][bj].z = cvt_pk_bf16(y1[0], y1[1]); w[m][bj].w = cvt_pk_bf16(y1[2], y1[3]); } }
#pragma unroll
            for (int mm = 0; mm < 4; ++mm) { bf16_t* rowp = O + (size_t)(row0 + ai * HALF + mm * 16) * ldc + col0;
#pragma unroll
                for (int bj = 0; bj < 2; ++bj) *(u32x4*)(rowp + bj * HALF) = w[mm][bj]; }
        }
#undef EPIIN_ROPE
    }
};
struct EpiPart {
    static constexpr bool PERM = false, AFTER_DRAIN = false;
    float* P;
    __device__ __forceinline__ void operator()(const f32x4 (&acc)[2][2][4][2], const Unit& u, int wr, int wc, int fr, int fq) const {
        float* pb = P + (size_t)u.ks * 1024 * 1024 + (size_t)((u.pm - 128) * BM + wr * 64 + fr) * 1024 + u.pn * BM + wc * 32 + 4 * fq;
#pragma unroll
        for (int ai = 0; ai < 2; ++ai)
#pragma unroll
            for (int m = 0; m < 4; ++m)
#pragma unroll
                for (int bj = 0; bj < 2; ++bj)
#pragma unroll
                    for (int n = 0; n < 2; ++n) *(f32x4*)(pb + (size_t)(ai * HALF + m * 16) * 1024 + bj * HALF + n * 16) = acc[ai][bj][m][n];
    }
};
__device__ __forceinline__ float silu_f(float x) { return x * __builtin_amdgcn_rcpf(1.0f + __builtin_amdgcn_exp2f(-1.4426950408889634f * x)); }
struct EpiSwiGLU {
    static constexpr bool PERM = true, AFTER_DRAIN = false;
    bf16_t* O; int ldc; int ntn;
    __device__ __forceinline__ void operator()(const f32x4 (&acc)[2][2][4][2], const Unit& u, int wr, int wc, int fr, int fq) const {
        const int row0 = u.pm * BM + wr * 64 + fr; const int col0 = (u.pn % ntn) * HALF + wc * 32 + 8 * fq;
#pragma unroll
        for (int ai = 0; ai < 2; ++ai)
#pragma unroll
            for (int m = 0; m < 4; ++m) { bf16_t* rowp = O + (size_t)(row0 + ai * HALF + m * 16) * ldc + col0;
                const f32x4 g0 = acc[ai][0][m][0], g1 = acc[ai][0][m][1], a0 = acc[ai][1][m][0], a1 = acc[ai][1][m][1];
                f32x4 d0, d1;
#pragma unroll
                for (int i = 0; i < 4; ++i) { d0[i] = __builtin_amdgcn_exp2f(g0[i]); d1[i] = __builtin_amdgcn_exp2f(g1[i]); }
                d0 = d0 + 1.0f; d1 = d1 + 1.0f;
                f32x4 r0, r1;
#pragma unroll
                for (int i = 0; i < 4; ++i) { r0[i] = __builtin_amdgcn_rcpf(d0[i]); r1[i] = __builtin_amdgcn_rcpf(d1[i]); }
                const f32x4 o0 = (g0 * a0) * r0, o1 = (g1 * a1) * r1;
                u32x4 w; w.x = cvt_pk_bf16(o0[0], o0[1]); w.y = cvt_pk_bf16(o0[2], o0[3]); w.z = cvt_pk_bf16(o1[0], o1[1]); w.w = cvt_pk_bf16(o1[2], o1[3]);
                *(u32x4*)rowp = w; }
    }
};
template <int MODE> struct EpiRes {
    static constexpr bool PERM = true, AFTER_DRAIN = false;
    bf16_t* hl; const float* gate; bf16_t* Y; int ntn;
    __device__ __forceinline__ void operator()(const f32x4 (&acc)[2][2][4][2], const Unit& u, int wr, int wc, int fr, int fq) const {
        const int r0 = wr * 64 + fr; const int colp = (u.pn % ntn) * BM + wc * 32 + 8 * fq;
        if constexpr (MODE == 0) {
            bf16_t* hb = hl + (size_t)(u.pm * BM + r0) * 1024 + colp;
            const float* gp = gate + (size_t)(u.pm >> 5) * 6144 + colp;
            u32x4 hv[2][2][4];
#pragma unroll
            for (int bj = 0; bj < 2; ++bj)
#pragma unroll
                for (int ai = 0; ai < 2; ++ai)
#pragma unroll
                    for (int m = 0; m < 4; ++m) hv[bj][ai][m] = *(const u32x4*)(hb + (size_t)(ai * HALF + m * 16) * 1024 + bj * HALF);
#pragma unroll
            for (int bj = 0; bj < 2; ++bj) { const f32x4 g0 = *(const f32x4*)(gp + bj * HALF), g1 = *(const f32x4*)(gp + bj * HALF + 4);
#pragma unroll
                for (int ai = 0; ai < 2; ++ai)
#pragma unroll
                    for (int m = 0; m < 4; ++m) { const f32x4 v0 = acc[ai][bj][m][0], v1 = acc[ai][bj][m][1]; const u32x4 h = hv[bj][ai][m];
                        u32x4 w;
                        w.x = cvt_pk_bf16(__builtin_bit_cast(float, h.x << 16) + g0[0] * v0[0], __builtin_bit_cast(float, h.x & 0xffff0000u) + g0[1] * v0[1]);
                        w.y = cvt_pk_bf16(__builtin_bit_cast(float, h.y << 16) + g0[2] * v0[2], __builtin_bit_cast(float, h.y & 0xffff0000u) + g0[3] * v0[3]);
                        w.z = cvt_pk_bf16(__builtin_bit_cast(float, h.z << 16) + g1[0] * v1[0], __builtin_bit_cast(float, h.z & 0xffff0000u) + g1[1] * v1[1]);
                        w.w = cvt_pk_bf16(__builtin_bit_cast(float, h.w << 16) + g1[2] * v1[2], __builtin_bit_cast(float, h.w & 0xffff0000u) + g1[3] * v1[3]);
                        *(u32x4*)(hb + (size_t)(ai * HALF + m * 16) * 1024 + bj * HALF) = w; } }
        } else {
            bf16_t* yb = Y + (size_t)(u.pm * BM + r0) * 1024 + colp;
#pragma unroll
            for (int ai = 0; ai < 2; ++ai)
#pragma unroll
                for (int m = 0; m < 4; ++m)
#pragma unroll
                    for (int bj = 0; bj < 2; ++bj) { if constexpr (MODE == 2) { if (!((u.hm >> (2 * ai + bj)) & 1)) continue; }
                        const f32x4 v0 = acc[ai][bj][m][0], v1 = acc[ai][bj][m][1];
                        u32x4 w; w.x = cvt_pk_bf16(v0[0], v0[1]); w.y = cvt_pk_bf16(v0[2], v0[3]); w.z = cvt_pk_bf16(v1[0], v1[1]); w.w = cvt_pk_bf16(v1[2], v1[3]);
                        *(u32x4*)(yb + (size_t)(ai * HALF + m * 16) * 1024 + bj * HALF) = w; }
        }
    }
};

template <class Epi, class Sched, bool ALIGN_EPI = false, bool SP2 = false, bool GATHER = false  >
__device__ __forceinline__ void gemm_phase(PG8_LAS unsigned char* lds, const Gemm g, const Sched& S, const Epi& E) {
    int tid_l = threadIdx.x; asm volatile("" : "+v"(tid_l));
    const int tid = tid_l, wid = __builtin_amdgcn_readfirstlane(tid >> 6), lane = tid & 63, wr = wid >> 2, wc = wid & 3, fr = lane & 15, fq = lane >> 4;
    const int K = g.K, nt = K / BK, LD = g.ld;
    unsigned voffA[2], voffB[2];
#pragma unroll
    for (int i = 0; i < 2; ++i) { int R, C; stage_rc(tid * 16 + i * 8192, R, C); const int Rb = Epi::PERM ? ((R & ~31) + perm32(R & 31)) : R;
        voffA[i] = (unsigned)(R * LD + C) * 2u; voffB[i] = (unsigned)(Rb * LD + C) * 2u; }
    const size_t kstep = (size_t)(BK * 2);
    const size_t hstep = (size_t)HALF * LD * 2;
    const size_t tstep = 2 * hstep;
    const unsigned ldsw = (unsigned)wid * 1024u;
    const int aoff = lds_byte(wr * 64 + fr, fq * 8), boff = lds_byte(wc * 32 + fr, fq * 8);
#define PG8_SA(b, h) (((b) * 2 + (h)) * HTB)
#define PG8_SB(b, h) ((4 + (b) * 2 + (h)) * HTB)
#define PG8_STAGE(bufoff, gbase, voff) do { _Pragma("unroll") for (int _i = 0; _i < 2; ++_i) \
        __builtin_amdgcn_global_load_lds((const unsigned*)((const char*)(gbase) + (voff)[_i]), (PG8_LAS unsigned*)(lds + (bufoff) + ldsw + _i * 8192), 16, 0, 0); } while (0)
#define PG8_STAGE_A(b, h, ptr, NX) do { if constexpr (GATHER) { _Pragma("unroll") for (int _i = 0; _i < 2; ++_i) \
        __builtin_amdgcn_global_load_lds((const unsigned*)((const char*)(ptr) + ((((NX) ? pkn[h] : pkc[h]) >> (16 * _i)) & 0xffffu) * (unsigned)(LD * 2) + gcol), (PG8_LAS unsigned*)(lds + PG8_SA(b, h) + ldsw + _i * 8192), 16, 0, 0); } \
        else { PG8_STAGE(PG8_SA(b, h), (ptr) + (h) * hstep, voffA); } } while (0)
#define PG8_LDA(dst, b, h) do { _Pragma("unroll") for (int m = 0; m < 4; ++m) _Pragma("unroll") for (int k = 0; k < 2; ++k) dst[m][k] = *(const PG8_LAS bf16x8*)(lds + PG8_SA(b, h) + aoff + m * 2048 + k * 1024); } while (0)
#define PG8_LDB(dst, b, h) do { _Pragma("unroll") for (int n = 0; n < 2; ++n) _Pragma("unroll") for (int k = 0; k < 2; ++k) dst[n][k] = *(const PG8_LAS bf16x8*)(lds + PG8_SB(b, h) + boff + n * 2048 + k * 1024); } while (0)
#define PG8_MMA(ai, bj, At, Bt) do { __builtin_amdgcn_s_setprio(1); _Pragma("unroll") for (int m = 0; m < 4; ++m) _Pragma("unroll") for (int n = 0; n < 2; ++n) _Pragma("unroll") for (int k = 0; k < 2; ++k) \
        acc[ai][bj][m][n] = __builtin_amdgcn_mfma_f32_16x16x32_bf16(Bt[n][k], At[m][k], acc[ai][bj][m][n], 0, 0, 0); __builtin_amdgcn_s_setprio(0); } while (0)
#define PG8_MMAG(ai, bj, At, Bt) do { if constexpr (Sched::TAIL) { if ((cur.hm >> (2 * (ai) + (bj))) & 1) PG8_MMA(ai, bj, At, Bt); } else PG8_MMA(ai, bj, At, Bt); } while (0)
#define PG8_WAIT_V(n) asm volatile("s_waitcnt vmcnt(" #n ")" ::: "memory")
#define PG8_WAIT_L(n) asm volatile("s_waitcnt lgkmcnt(" #n ")" ::: "memory")
#define PG8_BAR __builtin_amdgcn_s_barrier()
#define PG8_SCHED __builtin_amdgcn_sched_barrier(0)
    Unit cur, nxt; int ui = 0;
    if (!S.next(0, cur)) return;
    f32x4 acc[2][2][4][2];
#pragma unroll
    for (int a = 0; a < 2; ++a)
#pragma unroll
        for (int b = 0; b < 2; ++b)
#pragma unroll
            for (int m = 0; m < 4; ++m)
#pragma unroll
                for (int n = 0; n < 2; ++n) acc[a][b][m][n] = (f32x4){0.f, 0.f, 0.f, 0.f};
    bf16x8 At[4][2], B0[2][2], B1[2][2];
    const char* cA = (const char*)g.A + (GATHER ? (size_t)0 : (size_t)cur.pm * tstep) + cur.kofs; const char* cB = (const char*)g.Bt + (size_t)cur.pn * tstep + cur.kofs;
    unsigned pkc[2], pkn[2], gcol = 0;
#define PG8_GATHER(pk, u) do { _Pragma("unroll") for (int h_ = 0; h_ < 2; ++h_) { int R_, C_; stage_rc(tid * 16, R_, C_);          \
        const unsigned t0_ = (unsigned)g.tok[(u).pm * BM + h_ * HALF + R_], t1_ = (unsigned)g.tok[(u).pm * BM + h_ * HALF + R_ + 64]; pk[h_] = t0_ | (t1_ << 16); } } while (0)
    if constexpr (GATHER) { { int R_, C_; stage_rc(tid * 16, R_, C_); gcol = (unsigned)C_ * 2u; } PG8_GATHER(pkc, cur); pkn[0] = pkc[0]; pkn[1] = pkc[1]; }
    S.a_ready(cur);
    if constexpr (SP2) {
        PG8_STAGE(PG8_SB(0, 0), cB, voffB); PG8_STAGE(PG8_SB(0, 1), cB + hstep, voffB); PG8_STAGE_A(0, 0, cA, false); PG8_STAGE_A(0, 1, cA, false);
        if (wr == 1) PG8_BAR;
        PG8_WAIT_V(2); PG8_BAR;
        PG8_STAGE(PG8_SB(1, 0), cB + kstep, voffB); PG8_STAGE_A(1, 0, cA + kstep, false); PG8_STAGE(PG8_SB(1, 1), cB + hstep + kstep, voffB);
        PG8_WAIT_V(6); PG8_BAR;
    } else {
        PG8_STAGE(PG8_SB(0, 0), cB, voffB); PG8_STAGE_A(0, 0, cA, false); PG8_STAGE(PG8_SB(0, 1), cB + hstep, voffB); PG8_STAGE_A(0, 1, cA, false);
        if (wr == 1) PG8_BAR;
        PG8_WAIT_V(4); PG8_BAR;
        PG8_STAGE(PG8_SB(1, 0), cB + kstep, voffB); PG8_STAGE_A(1, 0, cA + kstep, false); PG8_STAGE(PG8_SB(1, 1), cB + hstep + kstep, voffB);
        PG8_WAIT_V(6); PG8_BAR;
    }
    for (;;) {
        const bool has_next = S.next(ui + 1, nxt);
        if constexpr (GATHER) { if (has_next) PG8_GATHER(pkn, nxt); }
        const char* nA = has_next ? (const char*)g.A + (GATHER ? (size_t)0 : (size_t)nxt.pm * tstep) + nxt.kofs : cA; const char* nB = has_next ? (const char*)g.Bt + (size_t)nxt.pn * tstep + nxt.kofs : cB;
        for (int t = 0; t < nt; t += 2) {
            const bool last = (t == nt - 2);
            const char* a1 = cA + (size_t)(t + 1) * kstep;
            const char* a2 = last ? nA : cA + (size_t)(t + 2) * kstep; const char* b2 = last ? nB : cB + (size_t)(t + 2) * kstep;
            const char* a3 = a2 + kstep; const char* b3 = b2 + kstep;
            if (last && has_next) S.a_ready(nxt);
            if constexpr (SP2) {
            PG8_LDB(B0, 0, 0); PG8_LDB(B1, 0, 1); PG8_SCHED; PG8_LDA(At, 0, 0); PG8_STAGE_A(1, 1, a1, false);
            PG8_WAIT_V(8); PG8_WAIT_L(0); PG8_BAR; PG8_MMAG(0, 0, At, B0); PG8_MMAG(0, 1, At, B1); PG8_BAR; PG8_SCHED;
            PG8_LDA(At, 0, 1); PG8_STAGE(PG8_SB(0, 0), b2, voffB); PG8_STAGE(PG8_SB(0, 1), b2 + hstep, voffB); PG8_STAGE_A(0, 0, a2, last);
            PG8_WAIT_V(8); PG8_WAIT_L(0); PG8_BAR; PG8_MMAG(1, 0, At, B0); PG8_MMAG(1, 1, At, B1); PG8_BAR; PG8_SCHED;
            PG8_LDB(B0, 1, 0); PG8_LDB(B1, 1, 1); PG8_SCHED; PG8_LDA(At, 1, 0); PG8_STAGE_A(0, 1, a2, last);
            PG8_WAIT_V(8); PG8_WAIT_L(0); PG8_BAR; PG8_MMAG(0, 0, At, B0); PG8_MMAG(0, 1, At, B1); PG8_BAR; PG8_SCHED;
            PG8_LDA(At, 1, 1); PG8_STAGE(PG8_SB(1, 0), b3, voffB); PG8_STAGE(PG8_SB(1, 1), b3 + hstep, voffB); PG8_STAGE_A(1, 0, a3, last);
            PG8_WAIT_V(8); PG8_WAIT_L(0); PG8_BAR; PG8_MMAG(1, 0, At, B0); PG8_MMAG(1, 1, At, B1); PG8_BAR; PG8_SCHED;
            } else {
            PG8_LDB(B0, 0, 0); PG8_SCHED; PG8_LDA(At, 0, 0); PG8_STAGE_A(1, 1, a1, false);
            PG8_WAIT_L(8); PG8_BAR; PG8_WAIT_L(0); PG8_MMA(0, 0, At, B0); PG8_BAR; PG8_SCHED;
            PG8_LDB(B1, 0, 1); PG8_STAGE(PG8_SB(0, 0), b2, voffB);
            PG8_BAR; PG8_WAIT_L(0); PG8_MMA(0, 1, At, B1); PG8_BAR;
            PG8_LDA(At, 0, 1); PG8_STAGE_A(0, 0, a2, last);
            PG8_BAR; PG8_WAIT_L(0); PG8_MMA(1, 0, At, B0); PG8_BAR; PG8_SCHED;
            PG8_STAGE(PG8_SB(0, 1), b2 + hstep, voffB);
            PG8_WAIT_V(6); PG8_BAR; PG8_MMA(1, 1, At, B1); PG8_BAR;
            PG8_LDB(B0, 1, 0); PG8_SCHED; PG8_LDA(At, 1, 0); PG8_STAGE_A(0, 1, a2, last);
            PG8_WAIT_L(8); PG8_BAR; PG8_WAIT_L(0); PG8_MMA(0, 0, At, B0); PG8_BAR; PG8_SCHED;
            PG8_LDB(B1, 1, 1); PG8_STAGE(PG8_SB(1, 0), b3, voffB);
            PG8_BAR; PG8_WAIT_L(0); PG8_MMA(0, 1, At, B1); PG8_BAR;
            PG8_LDA(At, 1, 1); PG8_STAGE_A(1, 0, a3, last);
            PG8_BAR; PG8_WAIT_L(0); PG8_MMA(1, 0, At, B0); PG8_BAR; PG8_SCHED;
            PG8_STAGE(PG8_SB(1, 1), b3 + hstep, voffB);
            PG8_WAIT_V(6); PG8_BAR; PG8_MMA(1, 1, At, B1); PG8_BAR;
            }
        }
        if constexpr (ALIGN_EPI) { if (wr == 0) PG8_BAR; }
        if constexpr (!Epi::AFTER_DRAIN) { E(acc, cur, wr, wc, fr, fq); S.done(cur); }
        if (!has_next) break;
#pragma unroll
        for (int a = 0; a < 2; ++a)
#pragma unroll
            for (int b = 0; b < 2; ++b)
#pragma unroll
                for (int m = 0; m < 4; ++m)
#pragma unroll
                    for (int n = 0; n < 2; ++n) acc[a][b][m][n] = (f32x4){0.f, 0.f, 0.f, 0.f};
        cur = nxt; cA = nA; cB = nB; ++ui;
        if constexpr (GATHER) { pkc[0] = pkn[0]; pkc[1] = pkn[1]; }
        if constexpr (ALIGN_EPI) { if (wr == 1) PG8_BAR; }
    }
    PG8_WAIT_V(0);
    if constexpr (!ALIGN_EPI) { if (wr == 0) PG8_BAR; }
    PG8_BAR;
    if constexpr (Epi::AFTER_DRAIN) { E.fused(acc, cur, wr, wc, fr, fq, lds, wid, lane); S.done(cur); }
#undef PG8_SA
#undef PG8_SB
#undef PG8_STAGE
#undef PG8_STAGE_A
#undef PG8_GATHER
#undef PG8_LDA
#undef PG8_LDB
#undef PG8_MMA
#undef PG8_MMAG
#undef PG8_WAIT_V
#undef PG8_WAIT_L
#undef PG8_BAR
#undef PG8_SCHED
}
}
constexpr int D = 1024, NB = 4, SEQ = 8192, CTXL = 256, NLAYER = 4;
constexpr int ML = NB * SEQ, MC = NB * CTXL, MT = ML + MC;
constexpr int DIN = 2304, DFF = 2816, DFE = 1408, NE = 8;
constexpr int ZQ = 1536, ZK = 2048, ZV = 2176;
constexpr float EPS = 1e-6f, LOG2E = 1.4426950408889634f, QSCALE = 0.125f * 1.4426950408889634f;
constexpr int MAXP = 272;
constexpr size_t MiB = 1u << 20;
constexpr size_t WS_CTL = 0, CTL_ZERO_BYTES = 1 * MiB;
constexpr size_t WS_MODS = 1 * MiB;
constexpr size_t WS_ROPE = 2 * MiB;
constexpr size_t WS_MOE = 3 * MiB;
constexpr size_t MOE_HIST = 0, MOE_PST = 8192, MOE_SEL = 8192 + 256, MOE_GATE = MOE_SEL + (size_t)MT * 4, MOE_SLOT = MOE_GATE + (size_t)MT * 8, MOE_TOK = MOE_SLOT + (size_t)MT * 8;
static_assert(MOE_TOK + (size_t)MAXP * 256 * 4 <= MiB, "moe tables");
constexpr size_t WS_HC = 4 * MiB;
constexpr size_t WS_WIN = 8 * MiB, WS_WOUT = 26 * MiB, WS_W13D = 34 * MiB, WS_W2D = 56 * MiB, WS_W13E = 67 * MiB, WS_W2E = 155 * MiB;
constexpr size_t WS_R0 = 200 * MiB;
constexpr size_t WS_U = 336 * MiB;
constexpr size_t WS_XN = 349 * MiB;
constexpr size_t WS_YC = 415 * MiB;
constexpr size_t WS_HB = 523 * MiB;
constexpr size_t WS_END = 587 * MiB;
static_assert(WS_R0 + (size_t)MT * DIN * 2 <= WS_XN && WS_R0 + (size_t)MAXP * 256 * 1024 * 2 <= WS_U && WS_U + (size_t)MAXP * 256 * DFE * 2 <= WS_HB && WS_U + (size_t)MT * DFF * 2 <= WS_HB && WS_HB + (size_t)ML * D * 2 <= WS_END && (size_t)11 * 4 * MiB <= (size_t)ML * D * 4, "ws map");
static_assert(WS_W2E + (size_t)16 * 1024 * DFE * 2 <= WS_R0, "ws map weights");
constexpr int RING_OFF = 0, RING_BYTES = 131072, LDSCTL_OFF = RING_BYTES, MISC_OFF = LDSCTL_OFF + 320, LDS_BYTES = 147456;
constexpr int NWAVES = 8, NTHR = 512;

#define GAS __attribute__((address_space(1)))
#define LAS __attribute__((address_space(3)))
typedef unsigned short bf16;
typedef unsigned v4u __attribute__((ext_vector_type(4)));
typedef unsigned v2u __attribute__((ext_vector_type(2)));
typedef float f32x4 __attribute__((ext_vector_type(4)));
typedef float f32x2 __attribute__((ext_vector_type(2)));
typedef short bf16x8 __attribute__((ext_vector_type(8)));
typedef GAS unsigned gu32;
#define RLX_AGENT __ATOMIC_RELAXED, __HIP_MEMORY_SCOPE_AGENT
#define LDS_WAIT() asm volatile("s_waitcnt lgkmcnt(0)" ::: "memory")
__device__ __forceinline__ unsigned pk2(float lo, float hi) { typedef __bf16 bf2 __attribute__((ext_vector_type(2))); f32x2 v = {lo, hi}; bf2 b = __builtin_convertvector(v, bf2); return __builtin_bit_cast(unsigned, b); }
__device__ __forceinline__ float bflo(unsigned w) { return __uint_as_float(w << 16); }
__device__ __forceinline__ float bfhi(unsigned w) { return __uint_as_float(w & 0xffff0000u); }
__device__ __forceinline__ float shx(float v, int o, int lane) { return __int_as_float(__builtin_amdgcn_ds_bpermute((lane ^ o) << 2, __float_as_int(v))); }
__device__ __forceinline__ float dpp_add(float v, const int ctrl_sel) {
    const int x = __float_as_int(v);
    const int y = ctrl_sel == 0 ? __builtin_amdgcn_update_dpp(0, x, 0xB1, 0xf, 0xf, true)
                : ctrl_sel == 1 ? __builtin_amdgcn_update_dpp(0, x, 0x4E, 0xf, 0xf, true)
                : ctrl_sel == 2 ? __builtin_amdgcn_update_dpp(0, x, 0x141, 0xf, 0xf, true)
                                : __builtin_amdgcn_update_dpp(0, x, 0x140, 0xf, 0xf, true);
    return v + __int_as_float(y);
}
__device__ __forceinline__ float wave_sum(float v, int lane) {
    (void)lane;
    v = dpp_add(v, 0); v = dpp_add(v, 1); v = dpp_add(v, 2); v = dpp_add(v, 3);
    const int x = __float_as_int(v);
    const float r0 = __int_as_float(__builtin_amdgcn_readlane(x, 0)), r1 = __int_as_float(__builtin_amdgcn_readlane(x, 16)), r2 = __int_as_float(__builtin_amdgcn_readlane(x, 32)), r3 = __int_as_float(__builtin_amdgcn_readlane(x, 48));
    return (r0 + r1) + (r2 + r3);
}
struct Args { const float* in[23]; float* out; unsigned char* ws; int ph_lo, ph_hi; };
#define XB_TMO      128
#define XB_XCNT(j)  (256  + 64 * (j))
#define XB_XSUB(j)  (1280 + 64 * (j))
#define XB_XGEN(j)  (2304 + 64 * (j))
#define XB_TOP      3328
#define XB_TOPGEN   3392
#define XCD_BAR_WORDS 3456
#define XB_SPIN_CAP (1u << 18)

__device__ __forceinline__ unsigned xb_ld(unsigned* p)              { return __hip_atomic_load(p, __ATOMIC_RELAXED, __HIP_MEMORY_SCOPE_AGENT); }
__device__ __forceinline__ unsigned xb_add(unsigned* p, unsigned v) { return __hip_atomic_fetch_add(p, v, __ATOMIC_RELAXED, __HIP_MEMORY_SCOPE_AGENT); }
__device__ __forceinline__ unsigned xb_xcc_id() { return (unsigned)__builtin_amdgcn_s_getreg((3 << 11) | 20) & 0xFu; }
#define XB_SPIN(cond, bar) do { unsigned _sp = 0; while (cond) { __builtin_amdgcn_s_sleep(1); \
    if ((++_sp & 255u) == 0u) { if (xb_ld(&(bar)[XB_TMO])) break; if (_sp > XB_SPIN_CAP) { atomicAdd(&(bar)[XB_TMO], 1u); break; } } } } while (0)

struct XcdBarrier {
    unsigned* bar; unsigned x;
    volatile LAS unsigned* st;
};

__device__ __forceinline__ XcdBarrier xcd_barrier_post(unsigned* bar, volatile LAS unsigned* st) {
    XcdBarrier b; b.bar = bar; b.x = xb_xcc_id(); b.st = st;
    if (threadIdx.x == 0) (void)xb_add(&bar[XB_XCNT(b.x)], 1u);
    return b;
}
__device__ __forceinline__ void xcd_barrier_complete(unsigned* bar, unsigned x, unsigned& nloc, unsigned& nx) {
    const unsigned G = gridDim.x * gridDim.y * gridDim.z;
    unsigned sum, cnt, mine, sp = 0u;
    for (;;) {
        sum = 0u; cnt = 0u; mine = 0u;
#pragma unroll
        for (unsigned j = 0; j < 16; ++j) { const unsigned c = xb_ld(&bar[XB_XCNT(j)]); sum += c; cnt += (c > 0u) ? 1u : 0u; mine = (j == x) ? c : mine; }
        if (sum == G) break;
        __builtin_amdgcn_s_sleep(1);
        if ((++sp & 255u) == 0u) { if (xb_ld(&bar[XB_TMO])) break; if (sp > XB_SPIN_CAP) { atomicAdd(&bar[XB_TMO], 1u); break; } }
    }
    nloc = mine > 0u ? mine : 1u; nx = cnt > 0u ? cnt : 1u;
}

__device__ __forceinline__ void xcd_barrier(const XcdBarrier& b) {
    asm volatile("s_waitcnt vmcnt(0)" ::: "memory");
    __syncthreads();
    if (threadIdx.x == 0) {
        unsigned* bar = b.bar;
        __builtin_amdgcn_s_waitcnt(0);
        unsigned nloc = b.st[0], nx = b.st[1];
        if (nloc == 0u) { xcd_barrier_complete(bar, b.x, nloc, nx); b.st[0] = nloc; b.st[1] = nx; }
        const unsigned old = xb_add(&bar[XB_XSUB(b.x)], 1u);
        const unsigned gen = old / nloc;
        if (old + 1u == (gen + 1u) * nloc) {
            __builtin_amdgcn_fence(__ATOMIC_RELEASE, "agent");
            asm volatile("s_waitcnt vmcnt(0)" ::: "memory");
            const unsigned og = xb_add(&bar[XB_TOP], 1u);
            const unsigned tg = og / nx;
            if (og + 1u == (tg + 1u) * nx) xb_add(&bar[XB_TOPGEN], 1u);
            else XB_SPIN(xb_ld(&bar[XB_TOPGEN]) == tg, bar);
            __builtin_amdgcn_fence(__ATOMIC_ACQUIRE, "agent");
            asm volatile("s_waitcnt vmcnt(0)" ::: "memory");
        } else {
            XB_SPIN(xb_ld(&bar[XB_TOPGEN]) == gen, bar);
            __builtin_amdgcn_fence(__ATOMIC_ACQUIRE, "agent");
            asm volatile("s_waitcnt vmcnt(0)" ::: "memory");
        }
    }
    __syncthreads();
}
typedef const __attribute__((address_space(4))) Args* CArgs;
__device__ __forceinline__ CArgs get_args() { CArgs p = (CArgs)__builtin_amdgcn_kernarg_segment_ptr(); asm volatile("" : "+s"(p)); return p; }
struct Frame {
    LAS unsigned char* lds;
    int tid, lane, wave, G, bid, gw, NGW;
    float* out; float* mods; f32x2* rope; float* hc; bf16* hb;
    bf16 *Z, *XG, *U, *XN, *YC;
    int* hist; int* pst; int* sel; f32x2* gates; int* slots; int* tok;
};
__device__ __forceinline__ void bind(Frame& F, CArgs ap) {
    unsigned char* ws = ap->ws; F.out = ap->out;
    F.mods = (float*)(ws + WS_MODS); F.rope = (f32x2*)(ws + WS_ROPE); F.hc = (float*)(ws + WS_HC); F.hb = (bf16*)(ws + WS_HB);
    F.Z = (bf16*)(ws + WS_R0); F.XG = (bf16*)(ws + WS_R0); F.U = (bf16*)(ws + WS_U); F.XN = (bf16*)(ws + WS_XN); F.YC = (bf16*)(ws + WS_YC);
    F.hist = (int*)(ws + WS_MOE + MOE_HIST); F.pst = (int*)(ws + WS_MOE + MOE_PST); F.sel = (int*)(ws + WS_MOE + MOE_SEL); F.gates = (f32x2*)(ws + WS_MOE + MOE_GATE); F.slots = (int*)(ws + WS_MOE + MOE_SLOT); F.tok = (int*)(ws + WS_MOE + MOE_TOK);
}

constexpr float SW_GATE = -1.4426950408889634f, SW_UP = -0.6931471805599453f;
__device__ __forceinline__ void p0_transpose_item(const float* W, int K, int N, bf16* WT, int il, LAS float* scr, int item, int lane, const float* kg0 = nullptr, const float* kg1 = nullptr, float wsc = 1.0f    ) {
    const int nblk = N / 32, kb = item / nblk, nb = item % nblk, k0 = 64 * kb, n0 = 32 * nb;
    int orow0 = n0; bool pq = false;
    if (il == 1 || il == 2) orow0 = 256 * (n0 >> 7) + (n0 & 127) + (il == 2 ? 128 : 0);
    if (il == 3 && n0 >= 512 && n0 < 1536) { const int hu = n0 >= 1024, c = (n0 - 512) & 511; orow0 = 512 + 256 * (c >> 7) + 128 * hu + (c & 127); }
    if (il == 3 && n0 >= 1536) {
        if (n0 < 2048) { const int h = (n0 - 1536) >> 6, bj = ((n0 - 1536) >> 5) & 1; orow0 = 1536 + 256 * (h >> 2) + 128 * bj + 32 * (h & 3); pq = true; }
        else if (n0 < 2176) { const int g = (n0 - 2048) >> 6, bj = ((n0 - 2048) >> 5) & 1; orow0 = 2048 + 128 * bj + 32 * g; pq = true; }
        else { const int g = (n0 - 2176) >> 6, dh = ((n0 - 2176) >> 5) & 1; orow0 = 2048 + 64 + 128 * dh + 32 * g; }
    }
    { float rv[32]; const float* wp = W + (size_t)(k0 + (lane >> 5)) * N + n0 + (lane & 31);
#pragma unroll
      for (int i = 0; i < 32; ++i) rv[i] = __builtin_nontemporal_load(wp + (size_t)(2 * i) * N);
      if (kg0) { const float* kg = (k0 < 512 ? kg0 + k0 : kg1 + (k0 - 512)) + (lane >> 5);
#pragma unroll
          for (int i = 0; i < 32; ++i) rv[i] *= kg[2 * i]; }
      if (wsc != 1.0f) {
#pragma unroll
          for (int i = 0; i < 32; ++i) rv[i] *= wsc; }
#pragma unroll
      for (int i = 0; i < 32; ++i) scr[(2 * i + (lane >> 5)) * 33 + (lane & 31)] = rv[i]; }
    LDS_WAIT(); asm volatile("" ::: "memory");
    const int c = lane & 7;
#pragma unroll
    for (int j = 0; j < 4; ++j) { const int n = (lane >> 3) + 8 * j; const LAS float* s = scr + (8 * c) * 33 + n; const int on = pq ? (8 * ((n >> 2) & 3) + 4 * (n >> 4) + (n & 3)) : n;
        v4u o; o.x = pk2(s[0 * 33], s[1 * 33]); o.y = pk2(s[2 * 33], s[3 * 33]); o.z = pk2(s[4 * 33], s[5 * 33]); o.w = pk2(s[6 * 33], s[7 * 33]);
        *(GAS v4u*)(WT + (size_t)(orow0 + on) * K + k0 + 8 * c) = o; }
    LDS_WAIT(); asm volatile("" ::: "memory");
}
constexpr int I_A = 16 * 72, I_B = 16 * 32, I_C = 16 * 88, I_D = 44 * 32, I_E = 16 * 44, I_F = 22 * 32;
__device__ __forceinline__ void conv_item(CArgs a, LAS float* scr, int lane, int cls, int m, int item) {
    if (cls == 0) { p0_transpose_item(a->in[8] + (size_t)m * 1024 * DIN, 1024, DIN, ((bf16*)(a->ws + WS_WIN)) + (size_t)m * DIN * 1024, 3, scr, item, lane); return; }
    if (cls == 1) { p0_transpose_item(a->in[15] + (size_t)m * 1024 * 1024, 1024, 1024, ((bf16*)(a->ws + WS_WOUT)) + (size_t)m * 1024 * 1024, 0, scr, item, lane, a->in[13] + m * 512, a->in[14] + m * 512); return; }
    if (cls == 2) { const int i = m >> 1, h = m & 1; p0_transpose_item((h ? a->in[17] : a->in[16]) + (size_t)i * 1024 * DFF, 1024, DFF, ((bf16*)(a->ws + WS_W13D)) + (size_t)i * 2 * DFF * 1024, 1 + h, scr, item, lane, nullptr, nullptr, h ? SW_UP : SW_GATE); return; }
    if (cls == 3) { p0_transpose_item(a->in[18] + (size_t)m * DFF * 1024, DFF, 1024, ((bf16*)(a->ws + WS_W2D)) + (size_t)m * 1024 * DFF, 0, scr, item, lane); return; }
    if (cls == 4) { const int ie = m >> 1, h = m & 1; p0_transpose_item((h ? a->in[21] : a->in[20]) + (size_t)ie * 1024 * DFE, 1024, DFE, ((bf16*)(a->ws + WS_W13E)) + (size_t)ie * 2 * DFE * 1024, 1 + h, scr, item, lane, nullptr, nullptr, h ? SW_UP : SW_GATE); return; }
    p0_transpose_item(a->in[22] + (size_t)m * DFE * 1024, DFE, 1024, ((bf16*)(a->ws + WS_W2E)) + (size_t)m * 1024 * DFE, 0, scr, item, lane);
}
constexpr int CONV_N0 = 2 * I_A + 2 * I_B + 2 * I_C + I_D + 16 * I_E + 8 * I_F, CONV_N1 = I_A + I_B + 2 * I_C + I_D, CONV_N2 = I_A + I_B + 16 * I_E + 8 * I_F;
__device__ __forceinline__ void conv_stage_item(CArgs a, LAS float* scr, int lane, int stage, int idx) {
    int r = idx;
    { const int m0 = stage == 0 ? 0 : stage + 1, cnt = stage == 0 ? 2 : 1; if (r < cnt * I_A) { conv_item(a, scr, lane, 0, m0 + r / I_A, r % I_A); return; } r -= cnt * I_A;
      if (r < cnt * I_B) { conv_item(a, scr, lane, 1, m0 + r / I_B, r % I_B); return; } r -= cnt * I_B; }
    if (stage != 2) { const int m0 = stage == 0 ? 0 : 2; if (r < 2 * I_C) { conv_item(a, scr, lane, 2, m0 + r / I_C, r % I_C); return; } r -= 2 * I_C;
        if (r < I_D) { conv_item(a, scr, lane, 3, stage, r); return; } r -= I_D; }
    if (stage != 1) { const int e0 = stage == 0 ? 0 : 16; if (r < 16 * I_E) { conv_item(a, scr, lane, 4, e0 + r / I_E, r % I_E); return; } r -= 16 * I_E;
        conv_item(a, scr, lane, 5, (stage == 0 ? 0 : 8) + r / I_F, r % I_F); }
}
__device__ __forceinline__ void p0_prologue(Frame& F, CArgs a) {
    LAS float* sc = (LAS float*)(F.lds + 73728); LAS float* red = (LAS float*)(F.lds + 73728 + 20480);
    for (int i = F.tid; i < 5120; i += NTHR) { const int r = i >> 10, k = i & 1023; const float x = r < 4 ? a->in[1][r * 1024 + k] : a->in[3][k]; sc[i] = x / (1.0f + expf(-x)); }
    __syncthreads();
    for (int it = F.bid; it < 384; it += F.G) {
        const int L = it / 96, jg = it % 96, col = jg * 64 + F.lane;
        const float* w = a->in[4] + ((size_t)L * 1024 + F.wave * 128) * 6144 + col;
        float a0 = 0.f, a1 = 0.f, a2 = 0.f, a3 = 0.f, a4 = 0.f;
#pragma unroll 8
        for (int kk = 0; kk < 128; ++kk) { const float wv = w[(size_t)kk * 6144]; const int k = F.wave * 128 + kk;
            a0 += sc[k] * wv; a1 += sc[1024 + k] * wv; a2 += sc[2048 + k] * wv; a3 += sc[3072 + k] * wv; a4 += sc[4096 + k] * wv; }
        red[(F.wave * 5 + 0) * 64 + F.lane] = a0; red[(F.wave * 5 + 1) * 64 + F.lane] = a1; red[(F.wave * 5 + 2) * 64 + F.lane] = a2; red[(F.wave * 5 + 3) * 64 + F.lane] = a3; red[(F.wave * 5 + 4) * 64 + F.lane] = a4;
        __syncthreads();
        if (F.wave < 5) { float s = a->in[5][(size_t)L * 6144 + col];
#pragma unroll
            for (int w8 = 0; w8 < 8; ++w8) s += red[(w8 * 5 + F.wave) * 64 + F.lane];
            F.mods[((size_t)L * 5 + F.wave) * 6144 + col] = s; }
        __syncthreads();
    }
    if (F.bid == 0) for (int i = F.tid; i < 2048; i += NTHR) { const int pos = i >> 4, fi = i & 15; const float inv = powf(10000.0f, -(float)fi / 16.0f); const float ang = (float)pos * inv; F.rope[i] = (f32x2){cosf(ang), sinf(ang)}; }
    LAS float* scr = (LAS float*)(F.lds + F.wave * 8704);
    for (int it = F.gw; it < CONV_N0; it += F.NGW) conv_stage_item(a, scr, F.lane, 0, it);
    for (int it = 6592 + 4416 + F.gw; it < CONV_N2; it += F.NGW) conv_stage_item(a, scr, F.lane, 2, it);
}
__device__ __forceinline__ void tail_convert(Frame& F, CArgs a, int stage, int lo, int hi, int first_idle) {
    if (F.bid < first_idle) return;
    LAS float* scr = (LAS float*)(F.lds + F.wave * 8704);
    const int w = (F.bid - first_idle) * NWAVES + F.wave, W = (F.G - first_idle) * NWAVES;
    for (int it = lo + w; it < hi; it += W) conv_stage_item(a, scr, F.lane, stage, it);
}

#define RC(lane, j) (8 * (lane) + 512 * ((j) >> 1) + 4 * ((j) & 1))
__device__ __forceinline__ void row_load(const float* p, int lane, f32x4 (&v)[4]) {
#pragma unroll
    for (int j = 0; j < 4; ++j) v[j] = *(const f32x4*)(p + RC(lane, j));
}
__device__ __forceinline__ void row_store(float* p, int lane, const f32x4 (&v)[4]) {
#pragma unroll
    for (int j = 0; j < 4; ++j) *(f32x4*)(p + RC(lane, j)) = v[j];
}
__device__ __forceinline__ void row_load_raw(const bf16* p, int lane, v4u (&r)[2]) { r[0] = *(const v4u*)(p + 8 * lane); r[1] = *(const v4u*)(p + 8 * lane + 512); }
__device__ __forceinline__ void row_unpack(const v4u (&r)[2], f32x4 (&v)[4]) {
#pragma unroll
    for (int q = 0; q < 2; ++q) { v[2 * q][0] = bflo(r[q].x); v[2 * q][1] = bfhi(r[q].x); v[2 * q][2] = bflo(r[q].y); v[2 * q][3] = bfhi(r[q].y);
        v[2 * q + 1][0] = bflo(r[q].z); v[2 * q + 1][1] = bfhi(r[q].z); v[2 * q + 1][2] = bflo(r[q].w); v[2 * q + 1][3] = bfhi(r[q].w); }
}
__device__ __forceinline__ void row_store_bf16(bf16* p, int lane, const f32x4 (&v)[4]) {
#pragma unroll
    for (int q = 0; q < 2; ++q) { v4u w; w.x = pk2(v[2 * q][0], v[2 * q][1]); w.y = pk2(v[2 * q][2], v[2 * q][3]); w.z = pk2(v[2 * q + 1][0], v[2 * q + 1][1]); w.w = pk2(v[2 * q + 1][2], v[2 * q + 1][3]);
        *(v4u*)(p + 8 * lane + 512 * q) = w; }
}
__device__ __forceinline__ void row_combine(const Frame& F, int row, int mr, int Lprev, int lane, f32x4 (&v)[4]) {
    const int s0 = F.slots[2 * row], s1 = F.slots[2 * row + 1]; const f32x2 g = F.gates[row];
    const bf16* y0 = (const bf16*)F.XG + (size_t)s0 * D; const bf16* y1 = (const bf16*)F.XG + (size_t)s1 * D;
    const float* g2 = F.mods + ((size_t)Lprev * 5 + mr) * 6144 + 5 * 1024;
#pragma unroll
    for (int q = 0; q < 2; ++q) { const int c = 8 * lane + 512 * q; const v4u a = *(const v4u*)(y0 + c), b = *(const v4u*)(y1 + c); const f32x4 gv0 = *(const f32x4*)(g2 + c), gv1 = *(const f32x4*)(g2 + c + 4);
        f32x4 t; t[0] = g.x * bflo(a.x) + g.y * bflo(b.x); t[1] = g.x * bfhi(a.x) + g.y * bfhi(b.x); t[2] = g.x * bflo(a.y) + g.y * bflo(b.y); t[3] = g.x * bfhi(a.y) + g.y * bfhi(b.y);
        v[2 * q] = v[2 * q] + gv0 * t;
        t[0] = g.x * bflo(a.z) + g.y * bflo(b.z); t[1] = g.x * bfhi(a.z) + g.y * bfhi(b.z); t[2] = g.x * bflo(a.w) + g.y * bflo(b.w); t[3] = g.x * bfhi(a.w) + g.y * bfhi(b.w);
        v[2 * q + 1] = v[2 * q + 1] + gv1 * t; }
}
__device__ __forceinline__ void row_add_parts(const float* P, int KS, int crow, const float* gate, int lane, f32x4 (&v)[4]) {
#pragma unroll
    for (int j = 0; j < 4; ++j) { const int c = RC(lane, j); const float* p = P + (size_t)crow * D + c; f32x4 s = *(const f32x4*)p;
        for (int ks = 1; ks < KS; ++ks) s = s + *(const f32x4*)(p + (size_t)ks * 1024 * 1024);
        v[j] = v[j] + *(const f32x4*)(gate + c) * s; }
}
__device__ __forceinline__ void row_norm_mod(const float* gain, const float* shift, const float* scale, int lane, f32x4 (&v)[4]) {
    float s = 0.f;
#pragma unroll
    for (int j = 0; j < 4; ++j) s += (v[j][0] * v[j][0] + v[j][1] * v[j][1]) + (v[j][2] * v[j][2] + v[j][3] * v[j][3]);
    const float rinv = 1.0f / sqrtf(wave_sum(s, lane) * (1.0f / D) + EPS);
#pragma unroll
    for (int j = 0; j < 4; ++j) { const int c = RC(lane, j); const f32x4 gn = *(const f32x4*)(gain + c), sh = *(const f32x4*)(shift + c), sc = *(const f32x4*)(scale + c);
        v[j] = (v[j] * rinv * gn) * (sc + 1.0f) + sh; }
}
struct RowMod { f32x4 G[4], S[4]; int mr; };
__device__ __forceinline__ void rowmod_set(RowMod& M, int mr, const float* gain, const float* shift, const float* scale, int lane) {
    if (mr == M.mr) return;
    M.mr = mr;
#pragma unroll
    for (int j = 0; j < 4; ++j) { const int c = RC(lane, j); const f32x4 gn = *(const f32x4*)(gain + c), sh = *(const f32x4*)(shift + c), sc = *(const f32x4*)(scale + c); M.G[j] = gn * (sc + 1.0f); M.S[j] = sh; }
}
__device__ __forceinline__ void row_norm_apply(const RowMod& M, int lane, f32x4 (&v)[4]) {
    float s = 0.f;
#pragma unroll
    for (int j = 0; j < 4; ++j) s += (v[j][0] * v[j][0] + v[j][1] * v[j][1]) + (v[j][2] * v[j][2] + v[j][3] * v[j][3]);
    const float rinv = 1.0f / sqrtf(wave_sum(s, lane) * (1.0f / D) + EPS);
#pragma unroll
    for (int j = 0; j < 4; ++j) v[j] = (v[j] * rinv) * M.G[j] + M.S[j];
}
__device__ __forceinline__ void row_combine_raw(const v4u (&ya)[2], const v4u (&yb)[2], const f32x2 g, const f32x4 (&g2v)[4], f32x4 (&v)[4]) {
#pragma unroll
    for (int q = 0; q < 2; ++q) { const v4u a = ya[q], b = yb[q]; const f32x4 gv0 = g2v[2 * q], gv1 = g2v[2 * q + 1];
        f32x4 t; t[0] = g.x * bflo(a.x) + g.y * bflo(b.x); t[1] = g.x * bfhi(a.x) + g.y * bfhi(b.x); t[2] = g.x * bflo(a.y) + g.y * bflo(b.y); t[3] = g.x * bfhi(a.y) + g.y * bfhi(b.y);
        v[2 * q] = v[2 * q] + gv0 * t;
        t[0] = g.x * bflo(a.z) + g.y * bflo(b.z); t[1] = g.x * bfhi(a.z) + g.y * bfhi(b.z); t[2] = g.x * bflo(a.w) + g.y * bflo(b.w); t[3] = g.x * bfhi(a.w) + g.y * bfhi(b.w);
        v[2 * q + 1] = v[2 * q + 1] + gv1 * t; }
}
template <bool FIN>
__device__ __forceinline__ void combine_rows(Frame& F, CArgs a, int L, int Lprev) {
    const float* gain = a->in[6] + (size_t)L * D;
    typedef int i32x2 __attribute__((ext_vector_type(2)));
    int row = F.gw; i32x2 sc = {0, 0}, sn = {0, 0}; f32x2 gc = {0.f, 0.f}, gn = {0.f, 0.f}; v4u hr[2], ya[2], yb[2];
    RowMod M; M.mr = -1; f32x4 g2v[4]; int g2mr = -1;
    if (row < ML) { sc = *(const i32x2*)(F.slots + 2 * row); gc = F.gates[row]; }
    if (row + F.NGW < ML) { sn = *(const i32x2*)(F.slots + 2 * (row + F.NGW)); gn = F.gates[row + F.NGW]; }
    if (row < ML) { row_load_raw(F.hb + (size_t)row * D, F.lane, hr); row_load_raw((const bf16*)F.XG + (size_t)sc.x * D, F.lane, ya); row_load_raw((const bf16*)F.XG + (size_t)sc.y * D, F.lane, yb); }
    while (row < ML) {
        f32x4 v[4]; row_unpack(hr, v); const v4u a0 = ya[0], a1 = ya[1], b0 = yb[0], b1 = yb[1]; const f32x2 g = gc;
        const int nrow = row + F.NGW;
        sc = sn; gc = gn;
        if (nrow + F.NGW < ML) { sn = *(const i32x2*)(F.slots + 2 * (nrow + F.NGW)); gn = F.gates[nrow + F.NGW]; }
        if (nrow < ML) { row_load_raw(F.hb + (size_t)nrow * D, F.lane, hr); row_load_raw((const bf16*)F.XG + (size_t)sc.x * D, F.lane, ya); row_load_raw((const bf16*)F.XG + (size_t)sc.y * D, F.lane, yb); }
        const int mr = row >> 13;
        if (mr != g2mr) { g2mr = mr; const float* g2 = F.mods + ((size_t)Lprev * 5 + mr) * 6144 + 5 * 1024;
#pragma unroll
            for (int j = 0; j < 4; ++j) g2v[j] = *(const f32x4*)(g2 + RC(F.lane, j)); }
        { const v4u ca[2] = {a0, a1}, cb[2] = {b0, b1}; row_combine_raw(ca, cb, g, g2v, v); }
        if (FIN) row_store(F.out + (size_t)row * D, F.lane, v);
        else { row_store_bf16(F.hb + (size_t)row * D, F.lane, v);
            const float* md = F.mods + ((size_t)L * 5 + mr) * 6144;
            rowmod_set(M, mr, gain, md, md + 1024, F.lane);
            row_norm_apply(M, F.lane, v);
            row_store_bf16(F.XN + (size_t)row * D, F.lane, v); }
        row = nrow;
    }
}
template <int MODE  >
__device__ __forceinline__ void norm1_rows(Frame& F, CArgs a, int L) {
    const float* gain = a->in[6] + (size_t)L * D;
    RowMod M; M.mr = -1;
    if (MODE == 0) {
        int row = F.gw; f32x4 vn[4];
        if (row < ML) row_load(a->in[0] + (size_t)row * D, F.lane, vn);
        while (row < ML) {
            f32x4 v[4];
#pragma unroll
            for (int j = 0; j < 4; ++j) v[j] = vn[j];
            const int nrow = row + F.NGW;
            if (nrow < ML) row_load(a->in[0] + (size_t)nrow * D, F.lane, vn);
            row_store_bf16(F.hb + (size_t)row * D, F.lane, v);
            const float* md = F.mods + ((size_t)L * 5 + (row >> 13)) * 6144;
            rowmod_set(M, row >> 13, gain, md, md + 1024, F.lane);
            row_norm_apply(M, F.lane, v);
            row_store_bf16(F.XN + (size_t)row * D, F.lane, v);
            row = nrow;
        }
    } else if (MODE == 2) {
        combine_rows<false>(F, a, L, L - 1);
    } else {
        int row = F.gw; v4u rn[2];
        if (row < ML) row_load_raw(F.hb + (size_t)row * D, F.lane, rn);
        while (row < ML) {
            f32x4 v[4]; row_unpack(rn, v);
            const int nrow = row + F.NGW;
            if (nrow < ML) row_load_raw(F.hb + (size_t)nrow * D, F.lane, rn);
            const int mr = row >> 13;
            const float* md = F.mods + ((size_t)L * 5 + mr) * 6144;
            rowmod_set(M, mr, gain, md, md + 1024, F.lane);
            row_norm_apply(M, F.lane, v);
            row_store_bf16(F.XN + (size_t)row * D, F.lane, v);
            row = nrow;
        }
    }
    for (int row = ML + F.gw; row < MT; row += F.NGW) {
        f32x4 v[4]; float* hp = F.hc + (size_t)(row - ML) * D;
        if (MODE == 0) row_load(a->in[2] + (size_t)(row - ML) * D, F.lane, v); else row_load(hp, F.lane, v);
        if (MODE == 2) row_combine(F, row, 4, L - 1, F.lane, v);
        if (MODE == 1) row_add_parts(a->out, 11, row - ML, F.mods + ((size_t)(L - 1) * 5 + 4) * 6144 + 5 * 1024, F.lane, v);
        row_store(hp, F.lane, v);
        const float* md = F.mods + ((size_t)L * 5 + 4) * 6144;
        row_norm_mod(gain, md, md + 1024, F.lane, v);
        row_store_bf16(F.XN + (size_t)row * D, F.lane, v);
    }
}
__device__ __forceinline__ void phase_norm1(Frame& F, CArgs a, int L) {
    if (L == 0) norm1_rows<0>(F, a, L); else if (L == 2) norm1_rows<2>(F, a, L); else norm1_rows<1>(F, a, L);
}
__device__ __forceinline__ void phase_norm2_dense(Frame& F, CArgs a, int L) {
    const float* gain = a->in[7] + (size_t)L * D;
    RowMod M; M.mr = -1;
    int row = F.gw; v4u rn[2];
    if (row < ML) row_load_raw(F.hb + (size_t)row * D, F.lane, rn);
    while (row < ML) {
        f32x4 v[4]; row_unpack(rn, v);
        const int nrow = row + F.NGW;
        if (nrow < ML) row_load_raw(F.hb + (size_t)nrow * D, F.lane, rn);
        const float* md = F.mods + ((size_t)L * 5 + (row >> 13)) * 6144;
        rowmod_set(M, row >> 13, gain, md + 3 * 1024, md + 4 * 1024, F.lane);
        row_norm_apply(M, F.lane, v);
        row_store_bf16(F.XG + (size_t)row * D, F.lane, v);
        row = nrow;
    }
    for (int row = ML + F.gw; row < MT; row += F.NGW) {
        f32x4 v[4]; float* hp = F.hc + (size_t)(row - ML) * D; row_load(hp, F.lane, v);
        const float* md = F.mods + ((size_t)L * 5 + 4) * 6144;
        row_add_parts(a->out, 4, row - ML, md + 2 * 1024, F.lane, v); row_store(hp, F.lane, v);
        row_norm_mod(gain, md + 3 * 1024, md + 4 * 1024, F.lane, v);
        row_store_bf16(F.XG + (size_t)row * D, F.lane, v);
    }
}
__device__ __forceinline__ int moe_row(int bid, int lr, int RPB) { return RPB == 128 ? bid * 128 + lr : (lr < 128 ? bid * 128 + lr : ML + bid * 4 + (lr - 128)); }
__device__ __forceinline__ void phase_norm2_moe(Frame& F, CArgs a, int L) {
    const int nrows = (L == NLAYER - 1) ? ML : MT, RPB = nrows / 256;
    const float* gain = a->in[7] + (size_t)L * D;
    LAS f32x4* rt = (LAS f32x4*)(F.lds);
    LAS int* esel = (LAS int*)(F.lds + 32768);
    const f32x4* rsrc = (const f32x4*)(a->in[19] + (size_t)(L >> 1) * D * NE);
    for (int i = F.tid; i < 2048; i += NTHR) { const int k = i >> 1, hf = i & 1, ln = (k & 511) >> 3, j = 2 * (k >> 9) + ((k >> 2) & 1), ii = k & 3; rt[((j * 4 + ii) * 2 + hf) * 64 + ln] = rsrc[i]; }
    __syncthreads();
    if (F.bid < 256) {
    v4u rn[2]; RowMod M; M.mr = -1;
    row_load_raw(F.hb + (size_t)moe_row(F.bid, F.wave, RPB) * D, F.lane, rn);
    for (int lr = F.wave; lr < RPB; lr += NWAVES) {
        const int row = moe_row(F.bid, lr, RPB); const int mr = row < ML ? (row >> 13) : 4;
        f32x4 v[4];
        if (row < ML) row_unpack(rn, v); else row_load(F.hc + (size_t)(row - ML) * D, F.lane, v);
        if (lr + NWAVES < 128) row_load_raw(F.hb + (size_t)(row + NWAVES) * D, F.lane, rn);
        const float* md = F.mods + ((size_t)L * 5 + mr) * 6144;
        if (row >= ML) { row_add_parts(a->out, 4, row - ML, md + 2 * 1024, F.lane, v); row_store(F.hc + (size_t)(row - ML) * D, F.lane, v); }
        rowmod_set(M, mr, gain, md + 3 * 1024, md + 4 * 1024, F.lane);
        row_norm_apply(M, F.lane, v);
        row_store_bf16(F.XG + (size_t)row * D, F.lane, v);
        float lg0 = 0.f, lg1 = 0.f, lg2 = 0.f, lg3 = 0.f, lg4 = 0.f, lg5 = 0.f, lg6 = 0.f, lg7 = 0.f;
#pragma unroll
        for (int j = 0; j < 4; ++j)
#pragma unroll
            for (int i = 0; i < 4; ++i) { const float x = v[j][i]; const f32x4 r0 = rt[((j * 4 + i) * 2) * 64 + F.lane], r1 = rt[((j * 4 + i) * 2 + 1) * 64 + F.lane];
                lg0 += x * r0[0]; lg1 += x * r0[1]; lg2 += x * r0[2]; lg3 += x * r0[3]; lg4 += x * r1[0]; lg5 += x * r1[1]; lg6 += x * r1[2]; lg7 += x * r1[3]; }
        lg0 = wave_sum(lg0, F.lane); lg1 = wave_sum(lg1, F.lane); lg2 = wave_sum(lg2, F.lane); lg3 = wave_sum(lg3, F.lane); lg4 = wave_sum(lg4, F.lane); lg5 = wave_sum(lg5, F.lane); lg6 = wave_sum(lg6, F.lane); lg7 = wave_sum(lg7, F.lane);
        int e0 = 0; float b0 = lg0;
        if (lg1 > b0) { b0 = lg1; e0 = 1; } if (lg2 > b0) { b0 = lg2; e0 = 2; } if (lg3 > b0) { b0 = lg3; e0 = 3; }
        if (lg4 > b0) { b0 = lg4; e0 = 4; } if (lg5 > b0) { b0 = lg5; e0 = 5; } if (lg6 > b0) { b0 = lg6; e0 = 6; } if (lg7 > b0) { b0 = lg7; e0 = 7; }
        int e1 = -1; float b1 = -INFINITY;
        if (e0 != 0 && lg0 > b1) { b1 = lg0; e1 = 0; } if (e0 != 1 && lg1 > b1) { b1 = lg1; e1 = 1; } if (e0 != 2 && lg2 > b1) { b1 = lg2; e1 = 2; } if (e0 != 3 && lg3 > b1) { b1 = lg3; e1 = 3; }
        if (e0 != 4 && lg4 > b1) { b1 = lg4; e1 = 4; } if (e0 != 5 && lg5 > b1) { b1 = lg5; e1 = 5; } if (e0 != 6 && lg6 > b1) { b1 = lg6; e1 = 6; } if (e0 != 7 && lg7 > b1) { b1 = lg7; e1 = 7; }
        if (e1 < 0) { e1 = (e0 + 1) & 7; b1 = b0; }
        const float t = expf(b1 - b0), g0 = 1.0f / (1.0f + t), g1 = t / (1.0f + t);
        if (F.lane == 0) { const int s = e0 | (e1 << 8); F.sel[row] = s; F.gates[row] = (f32x2){g0, g1}; esel[lr] = s; }
    }
    }
    __syncthreads();
    if (F.tid < 8 && F.bid < 256) { int cnt = 0; for (int lr = 0; lr < RPB; ++lr) { const int s = esel[lr]; cnt += ((s & 255) == F.tid) + ((s >> 8) == F.tid); } F.hist[F.bid * 8 + F.tid] = cnt; }
}
__device__ __forceinline__ void phase_slots(Frame& F, int L) {
    const int nrows = (L == NLAYER - 1) ? ML : MT, RPB = nrows / 256;
    LAS int* hl = (LAS int*)F.lds; LAS int* tot = hl + 2048; LAS int* pre = tot + 8; LAS int* rbase = pre + 8; LAS int* slotl = rbase + 8;
    LAS int* sell = slotl + 2 * 132;
    for (int i = F.tid; i < 2048; i += NTHR) hl[i] = F.hist[i];
    if (F.bid < 256) for (int i = F.tid; i < RPB; i += NTHR) sell[i] = F.sel[moe_row(F.bid, i, RPB)];
    __syncthreads();
    if (F.tid < 8) { int t = 0, p = 0; for (int b = 0; b < 256; ++b) { const int h = hl[b * 8 + F.tid]; if (b < F.bid) p += h; t += h; } tot[F.tid] = t; pre[F.tid] = p; }
    __syncthreads();
    if (F.tid == 0) { int ps = 0; for (int e = 0; e < 8; ++e) { rbase[e] = ps * 256 + pre[e]; if (F.bid == 0) F.pst[e] = ps; ps += (tot[e] + 255) >> 8; } if (F.bid == 0) F.pst[8] = ps; }
    __syncthreads();
    if (F.bid < 256) {
    if (F.tid < 8) { int off = rbase[F.tid]; for (int lr = 0; lr < RPB; ++lr) { const int s = sell[lr]; if ((s & 255) == F.tid) slotl[2 * lr] = off++; if ((s >> 8) == F.tid) slotl[2 * lr + 1] = off++; } }
    }
    __syncthreads();
    if (F.bid < 256) {
    for (int lr = F.tid; lr < RPB; lr += NTHR) { const int row = moe_row(F.bid, lr, RPB); const int s0 = slotl[2 * lr], s1 = slotl[2 * lr + 1];
        F.slots[2 * row] = s0; F.slots[2 * row + 1] = s1; F.tok[s0] = row; F.tok[s1] = row; }
    }
    if (F.bid == 0 && F.tid < 8) { const int e = F.tid; int ps = 0; for (int q = 0; q < e; ++q) ps += (tot[q] + 255) >> 8;
        const int s1 = (ps + ((tot[e] + 255) >> 8)) * 256; int z = 0; asm volatile("" : "+v"(z));
        for (int s = ps * 256 + tot[e]; s < s1; ++s) F.tok[s] = z; }
}
__device__ __forceinline__ void unpack8(const v4u w, float (&f)[8]) { f[0] = bflo(w.x); f[1] = bfhi(w.x); f[2] = bflo(w.y); f[3] = bfhi(w.y); f[4] = bflo(w.z); f[5] = bfhi(w.z); f[6] = bflo(w.w); f[7] = bfhi(w.w); }
__device__ __forceinline__ void phase_convnorm(Frame& F, CArgs a, int L, int gw, int ngw) {
    const int nrows = (L == NLAYER - 1) ? ML : MT; const int c8 = F.lane * 8;
    const float* cw = a->in[9] + (size_t)L * 3 * 512;
    float w0[8], w1[8], w2[8];
#pragma unroll
    for (int i = 0; i < 8; ++i) { w0[i] = cw[c8 + i]; w1[i] = cw[512 + c8 + i]; w2[i] = cw[1024 + c8 + i]; }
    const int RPW = (nrows + ngw - 1) / ngw; int row = gw * RPW; const int rend = (row + RPW < nrows) ? row + RPW : nrows;
    if (row >= rend) return;
    const int rmax = nrows - 1;
#define CONV_U(r) (*(const v4u*)(F.Z + (size_t)((r) < 0 ? 0 : ((r) > rmax ? rmax : (r))) * DIN + 512 + c8))
#define CONV_BG(r) (*(const v4u*)(F.Z + (size_t)((r) > rmax ? rmax : (r)) * DIN + c8))
    v4u up = CONV_U(row - 1), uc = CONV_U(row), un = CONV_U(row + 1), bgc = CONV_BG(row);
    for (; row < rend; ++row) {
        const v4u un2 = CONV_U(row + 2), bgn = CONV_BG(row + 1);
        const bool lat = row < ML; const int tt = lat ? (row & (SEQ - 1)) : ((row - ML) & (CTXL - 1)); const int tlen = lat ? SEQ : CTXL;
        float bg[8], uu[8], y[8];
        unpack8(bgc, bg); unpack8(uc, uu);
#pragma unroll
        for (int i = 0; i < 8; ++i) y[i] = w1[i] * uu[i];
        if (tt > 0) { unpack8(up, uu);
#pragma unroll
            for (int i = 0; i < 8; ++i) y[i] += w0[i] * uu[i]; }
        if (tt < tlen - 1) { unpack8(un, uu);
#pragma unroll
            for (int i = 0; i < 8; ++i) y[i] += w2[i] * uu[i]; }
        float s = 0.f;
#pragma unroll
        for (int i = 0; i < 8; ++i) { y[i] *= bg[i]; s += y[i] * y[i]; }
        const float rinv = 1.0f / sqrtf(wave_sum(s, F.lane) * (1.0f / 512.0f) + EPS);
        v4u o; o.x = pk2(y[0] * rinv, y[1] * rinv); o.y = pk2(y[2] * rinv, y[3] * rinv); o.z = pk2(y[4] * rinv, y[5] * rinv); o.w = pk2(y[6] * rinv, y[7] * rinv);
        *(v4u*)(F.YC + (size_t)row * D + c8) = o;
        up = uc; uc = un; un = un2; bgc = bgn;
    }
#undef CONV_U
#undef CONV_BG
}
__device__ __forceinline__ void phase_final(Frame& F, CArgs a) { combine_rows<true>(F, a, 0, NLAYER - 1); }
namespace att {
typedef short s16x4 __attribute__((ext_vector_type(4)));
typedef float f32x16 __attribute__((ext_vector_type(16)));
constexpr int TILE_B = 32768, GRP_B = 16384, L_K = 0, L_V = 8192, L_SS = 2 * TILE_B, L_OST = L_SS + 1024, L_END = L_OST + 8 * 4096;
static_assert(L_END <= RING_BYTES, "attention LDS map");
__device__ __forceinline__ int crow(int r, int hi) { return (r & 3) + 8 * (r >> 2) + 4 * hi; }
__device__ __forceinline__ void pv(f32x16* o, int vb, bf16x8 pa0, bf16x8 pa1, bf16x8 pa2, bf16x8 pa3) {
    s16x4 lo[8], hi[8];
#pragma unroll
    for (int d0 = 0; d0 < 2; ++d0)
#pragma unroll
        for (int ks = 0; ks < 4; ++ks) {
            asm volatile("ds_read_b64_tr_b16 %0,%1 offset:%c2" : "=&v"(lo[d0 * 4 + ks]) : "v"(vb), "i"(d0 * 4096 + ks * 1024) : "memory");
            asm volatile("ds_read_b64_tr_b16 %0,%1 offset:%c2" : "=&v"(hi[d0 * 4 + ks]) : "v"(vb), "i"(d0 * 4096 + ks * 1024 + 512) : "memory"); }
    asm volatile("s_waitcnt lgkmcnt(0)" ::: "memory"); __builtin_amdgcn_sched_barrier(0);
#define PK(k) (bf16x8){lo[k][0], lo[k][1], lo[k][2], lo[k][3], hi[k][0], hi[k][1], hi[k][2], hi[k][3]}
    o[0] = __builtin_amdgcn_mfma_f32_32x32x16_bf16(PK(0), pa0, o[0], 0, 0, 0); o[1] = __builtin_amdgcn_mfma_f32_32x32x16_bf16(PK(4), pa0, o[1], 0, 0, 0);
    o[0] = __builtin_amdgcn_mfma_f32_32x32x16_bf16(PK(1), pa1, o[0], 0, 0, 0); o[1] = __builtin_amdgcn_mfma_f32_32x32x16_bf16(PK(5), pa1, o[1], 0, 0, 0);
    o[0] = __builtin_amdgcn_mfma_f32_32x32x16_bf16(PK(2), pa2, o[0], 0, 0, 0); o[1] = __builtin_amdgcn_mfma_f32_32x32x16_bf16(PK(6), pa2, o[1], 0, 0, 0);
    o[0] = __builtin_amdgcn_mfma_f32_32x32x16_bf16(PK(3), pa3, o[0], 0, 0, 0); o[1] = __builtin_amdgcn_mfma_f32_32x32x16_bf16(PK(7), pa3, o[1], 0, 0, 0);
#undef PK
}
__device__ __forceinline__ void softmax_tile(f32x16& p0, f32x16& p1, float& l, bool masked, int kq0  , int hi) {
    if (masked) { int nb_ = (int)0xff800000u; asm volatile("" : "+s"(nb_)); const float ninf = __int_as_float(nb_);
#pragma unroll
        for (int r = 0; r < 16; ++r) { const int d0 = kq0 + crow(r, hi), d1 = d0 + 32;
            if (d0 > 128 || d0 < -128) p0[r] = ninf;
            if (d1 > 128 || d1 < -128) p1[r] = ninf; }
    }
    float s0 = 0.f, s1 = 0.f, s2 = 0.f, s3 = 0.f;
#pragma unroll
    for (int r = 0; r < 16; r += 2) { p0[r] = __builtin_amdgcn_exp2f(p0[r]); p0[r + 1] = __builtin_amdgcn_exp2f(p0[r + 1]); p1[r] = __builtin_amdgcn_exp2f(p1[r]); p1[r + 1] = __builtin_amdgcn_exp2f(p1[r + 1]);
        s0 += p0[r]; s1 += p0[r + 1]; s2 += p1[r]; s3 += p1[r + 1]; }
    l += (s0 + s1) + (s2 + s3);
}
#define ATT_PACK(pw, p0, p1) do { pw[0] = (v4u){pk2(p0[0], p0[1]), pk2(p0[2], p0[3]), pk2(p0[4], p0[5]), pk2(p0[6], p0[7])}; pw[1] = (v4u){pk2(p0[8], p0[9]), pk2(p0[10], p0[11]), pk2(p0[12], p0[13]), pk2(p0[14], p0[15])}; \
        pw[2] = (v4u){pk2(p1[0], p1[1]), pk2(p1[2], p1[3]), pk2(p1[4], p1[5]), pk2(p1[6], p1[7])}; pw[3] = (v4u){pk2(p1[8], p1[9]), pk2(p1[10], p1[11]), pk2(p1[12], p1[13]), pk2(p1[14], p1[15])}; } while (0)
__device__ __forceinline__ void unit8(LAS unsigned char* lds, const bf16* Z, bf16* YC, const float* sinkp, int b, int qrow0, int qpos0, int lane, int wid) {
    const int r32 = lane & 31, hi = lane >> 5, g = wid >> 2, hq = 4 * g + 2 * ((wid >> 1) & 1), pr = wid & 1;
    int seqm1 = SEQ - 1; asm volatile("" : "+s"(seqm1));
    int tw0 = 0, nwin = 0;
    if (qpos0 >= 0) { tw0 = (128 - qpos0) > 0 ? (128 - qpos0 + 63) / 64 : 0; int tw1 = (SEQ - 1 + 128 - qpos0) / 64; if (tw1 > 4) tw1 = 4; nwin = tw1 - tw0 + 1; }
    const int NT = nwin + 4;
    const bf16* kbase = Z + 2048 + 128 * (wid >> 2) + 8 * (wid & 3);
    const bf16* vbase = Z + 2048 + 64 + 128 * (wid >> 2) + (lane & 3) * 8;
#define ATT_DMA(i, buf) do { int krow_, vrow_; if ((i) < nwin) { const int kp0_ = qpos0 - 128 + 64 * (tw0 + (i)); int kp_ = kp0_ + lane; kp_ = kp_ < 0 ? 0 : (kp_ > seqm1 ? seqm1 : kp_); krow_ = b * SEQ + kp_; \
        int vp_ = kp0_ + 16 * (wid & 3) + (lane >> 2); vp_ = vp_ < 0 ? 0 : (vp_ > seqm1 ? seqm1 : vp_); vrow_ = b * SEQ + vp_; } \
        else { const int j_ = (i) - nwin; krow_ = ML + b * CTXL + 64 * j_ + lane; vrow_ = ML + b * CTXL + 64 * j_ + 16 * (wid & 3) + (lane >> 2); } \
        const bf16* kp__ = kbase + (size_t)krow_ * DIN; const bf16* vp__ = vbase + (size_t)vrow_ * DIN; LAS unsigned char* d_ = lds + (buf) * TILE_B + wid * 1024; \
        __builtin_amdgcn_global_load_lds((const unsigned*)kp__, (LAS unsigned*)(d_ + L_K), 16, 0, 0); __builtin_amdgcn_global_load_lds((const unsigned*)(kp__ + 32), (LAS unsigned*)(d_ + GRP_B + L_K), 16, 0, 0); \
        __builtin_amdgcn_global_load_lds((const unsigned*)vp__, (LAS unsigned*)(d_ + L_V), 16, 0, 0); __builtin_amdgcn_global_load_lds((const unsigned*)(vp__ + 32), (LAS unsigned*)(d_ + GRP_B + L_V), 16, 0, 0); } while (0)
    ATT_DMA(0, 0); ATT_DMA(1, 1);
    bf16x8 qr[2][4];
#pragma unroll
    for (int hh = 0; hh < 2; ++hh) { const bf16* Qw = Z + (size_t)(qrow0 + 32 * pr + r32) * DIN + 1536 + 256 * g + 32 * ((hq + hh) & 3) + hi * 8;
#pragma unroll
        for (int d0 = 0; d0 < 4; ++d0) qr[hh][d0] = *(const bf16x8*)(Qw + 128 * (d0 >> 1) + 16 * (d0 & 1)); }
    float l[2]; f32x16 o[2][2];
#pragma unroll
    for (int hh = 0; hh < 2; ++hh) { l[hh] = (hi == 0) ? __builtin_amdgcn_exp2f(sinkp[hq + hh] * LOG2E) : 0.0f; o[hh][0] = f32x16{}; o[hh][1] = f32x16{}; }
    const int vb0 = (int)(unsigned)(uintptr_t)(lds + g * GRP_B + L_V) + ((lane >> 4) & 1) * 32 + (lane & 3) * 8 + (4 * hi + ((lane & 15) >> 2)) * 64;
    const LAS unsigned char* kb0 = lds + g * GRP_B + L_K + hi * 1024 + r32 * 16;
    asm volatile("s_waitcnt vmcnt(0)" ::: "memory");
    __syncthreads();
#pragma nounroll
    for (int i = 0; i < NT; ++i) {
        const int bo = (i & 1) * TILE_B;
        bool need = true, masked = false; int kq0 = 0;
        if (i < nwin) { const int k0 = -128 + 64 * (tw0 + i), r0 = 32 * pr; need = (k0 + 63 >= r0 - 128) && (k0 <= r0 + 31 + 128); masked = !((k0 >= r0 + 31 - 128) && (k0 + 63 <= r0 + 128)); kq0 = k0 - r0 - r32; }
        if (need) {
            v4u pw[2][4];
            { bf16x8 kf[8];
#pragma unroll
              for (int d0 = 0; d0 < 4; ++d0) { kf[2 * d0] = *(const LAS bf16x8*)(kb0 + bo + d0 * 2048); kf[2 * d0 + 1] = *(const LAS bf16x8*)(kb0 + bo + d0 * 2048 + 512); }
#pragma unroll
              for (int hh = 0; hh < 2; ++hh) { f32x16 p0 = f32x16{}, p1 = f32x16{};
                  __builtin_amdgcn_s_setprio(1);
#pragma unroll
                  for (int d0 = 0; d0 < 4; ++d0) { p0 = __builtin_amdgcn_mfma_f32_32x32x16_bf16(kf[2 * d0], qr[hh][d0], p0, 0, 0, 0); p1 = __builtin_amdgcn_mfma_f32_32x32x16_bf16(kf[2 * d0 + 1], qr[hh][d0], p1, 0, 0, 0); }
                  __builtin_amdgcn_s_setprio(0);
                  softmax_tile(p0, p1, l[hh], masked, kq0, hi);
                  ATT_PACK(pw[hh], p0, p1); } }
            { s16x4 vlo[8], vhi[8]; const int vb = vb0 + bo;
#pragma unroll
              for (int d0 = 0; d0 < 2; ++d0)
#pragma unroll
                  for (int ks = 0; ks < 4; ++ks) {
                      asm volatile("ds_read_b64_tr_b16 %0,%1 offset:%c2" : "=&v"(vlo[d0 * 4 + ks]) : "v"(vb), "i"(d0 * 4096 + ks * 1024) : "memory");
                      asm volatile("ds_read_b64_tr_b16 %0,%1 offset:%c2" : "=&v"(vhi[d0 * 4 + ks]) : "v"(vb), "i"(d0 * 4096 + ks * 1024 + 512) : "memory"); }
              asm volatile("s_waitcnt lgkmcnt(0)" ::: "memory"); __builtin_amdgcn_sched_barrier(0);
              __builtin_amdgcn_s_setprio(1);
#define PK(k) (bf16x8){vlo[k][0], vlo[k][1], vlo[k][2], vlo[k][3], vhi[k][0], vhi[k][1], vhi[k][2], vhi[k][3]}
#pragma unroll
              for (int ks = 0; ks < 4; ++ks)
#pragma unroll
                  for (int hh = 0; hh < 2; ++hh) { o[hh][0] = __builtin_amdgcn_mfma_f32_32x32x16_bf16(PK(ks), __builtin_bit_cast(bf16x8, pw[hh][ks]), o[hh][0], 0, 0, 0);
                      o[hh][1] = __builtin_amdgcn_mfma_f32_32x32x16_bf16(PK(4 + ks), __builtin_bit_cast(bf16x8, pw[hh][ks]), o[hh][1], 0, 0, 0); }
              __builtin_amdgcn_s_setprio(0);
#undef PK
            }
        }
        asm volatile("s_waitcnt vmcnt(0)" ::: "memory");
        __syncthreads();
        if (i + 2 < NT) ATT_DMA(i + 2, i & 1);
    }
#undef ATT_DMA
    LAS float* ss = (LAS float*)(lds + L_SS);
    float rl[2], sq = 0.f;
#pragma unroll
    for (int hh = 0; hh < 2; ++hh) { float lt = l[hh]; lt += shx(lt, 32, lane); rl[hh] = 1.0f / lt; float s = 0.f;
#pragma unroll
        for (int d0 = 0; d0 < 2; ++d0)
#pragma unroll
            for (int r = 0; r < 16; ++r) { const float t = o[hh][d0][r] * rl[hh]; s += t * t; }
        sq += s; }
    sq += shx(sq, 32, lane);
    if (hi == 0) ss[(32 * pr + r32) * 4 + (wid >> 1)] = sq;
    __syncthreads();
    float rinv; { const f32x4 t = *(const LAS f32x4*)(ss + (32 * pr + r32) * 4); rinv = 1.0f / sqrtf(((t[0] + t[1]) + (t[2] + t[3])) * (1.0f / 512.0f) + EPS); }
    LAS bf16* stg = (LAS bf16*)(lds + L_OST) + wid * 2048;
#pragma unroll
    for (int hh = 0; hh < 2; ++hh) {
        const float sc = rl[hh] * rinv;
#pragma unroll
        for (int d0 = 0; d0 < 2; ++d0)
#pragma unroll
            for (int gq = 0; gq < 4; ++gq) { v2u w; w.x = pk2(o[hh][d0][4 * gq] * sc, o[hh][d0][4 * gq + 1] * sc); w.y = pk2(o[hh][d0][4 * gq + 2] * sc, o[hh][d0][4 * gq + 3] * sc);
                *(LAS v2u*)(stg + r32 * 64 + 32 * d0 + 8 * gq + 4 * hi) = w; }
        asm volatile("s_waitcnt lgkmcnt(0)" ::: "memory");
        bf16* Ow = YC + (size_t)(qrow0 + 32 * pr) * D + 512 + (hq + hh) * 64;
#pragma unroll
        for (int i = 0; i < 4; ++i) { const int row = i * 8 + (lane >> 3), ch = lane & 7; const v4u v = *(const LAS v4u*)(stg + row * 64 + ch * 8); *(v4u*)(Ow + (size_t)row * D + ch * 8) = v; }
        asm volatile("s_waitcnt lgkmcnt(0)" ::: "memory");
    }
}
}
__device__ __forceinline__ void phase_attn(Frame& F, CArgs a, int L) {
    const float* sinkp = a->in[12] + L * 8;
    for (int u = F.bid; u < 512; u += F.G) { const int b = u >> 7, qb = u & 127;
        att::unit8(F.lds, F.Z, F.YC, sinkp, b, b * SEQ + qb * 64, qb * 64, F.lane, F.wave); }
    const bool ctxu = (L != NLAYER - 1);
    if (ctxu && F.bid < 16) { const int b = F.bid >> 2, qb = F.bid & 3; att::unit8(F.lds, F.Z, F.YC, sinkp, b, ML + b * CTXL + qb * 64, -1, F.lane, F.wave); return; }
    const int nb0 = ctxu ? 16 : 0;
    phase_convnorm(F, a, L, (F.bid - nb0) * NWAVES + F.wave, (F.G - nb0) * NWAVES);
}
constexpr int NPH = 42;
__global__ void __launch_bounds__(NTHR, 2) fwd(Args args_unused) {
    extern __shared__ __attribute__((aligned(16))) unsigned char lds[];
    for (int u = threadIdx.x; u < (LDS_BYTES - LDSCTL_OFF) / 4; u += NTHR) ((LAS unsigned*)((LAS unsigned char*)lds + LDSCTL_OFF))[u] = 0u;
    __syncthreads();
    int lo, hi; { CArgs a0 = get_args(); lo = a0->ph_lo; hi = a0->ph_hi; }
    if (hi - lo > 1) { CArgs a0 = get_args(); (void)xcd_barrier_post((unsigned*)(a0->ws + WS_CTL) + 4096, (volatile LAS unsigned*)((LAS unsigned char*)lds + MISC_OFF) + 8); }
#define FRAME() Frame F; { int t_ = threadIdx.x, b_ = blockIdx.x, g_ = gridDim.x; asm volatile("" : "+v"(t_)); asm volatile("" : "+s"(b_), "+s"(g_)); \
        F.lds = (LAS unsigned char*)lds; F.tid = t_; F.lane = t_ & 63; F.wave = __builtin_amdgcn_readfirstlane(t_ >> 6); F.G = g_; F.bid = b_; F.gw = b_ * NWAVES + F.wave; F.NGW = g_ * NWAVES; }
#define IN(k) (lo <= (k) && (k) < hi)
#define SEAM(k) do { if ((k) + 1 < hi) { CArgs a_ = get_args(); XcdBarrier b_; b_.bar = (unsigned*)(a_->ws + WS_CTL) + 4096; b_.x = xb_xcc_id(); b_.st = (volatile LAS unsigned*)((LAS unsigned char*)lds + MISC_OFF) + 8; xcd_barrier(b_); } } while (0)
    if (IN(0)) { FRAME(); CArgs ap = get_args(); bind(F, ap); p0_prologue(F, ap); SEAM(0); }
    for (int L = 0; L < NLAYER; ++L) {
        const int pb = 1 + 10 * L; const bool last = (L == NLAYER - 1), moe = (L & 1) != 0;
        if (IN(pb + 0)) { FRAME(); CArgs ap = get_args(); bind(F, ap); phase_norm1(F, ap, L); SEAM(pb + 0); }
        if (IN(pb + 1)) {
            FRAME(); CArgs ap = get_args(); unsigned char* ws = ap->ws;
            pg8::Gemm g{(const bf16*)(ws + WS_XN), (const bf16*)(ws + WS_WIN) + (size_t)L * DIN * 1024, 1024, 1024, nullptr}; pg8::Sched S; S.init(MT / 256, DIN / 256, F.G, F.bid);
            pg8::EpiIn E{(bf16*)(ws + WS_R0), ap->in[10] + L * 64, ap->in[11] + L * 64, (const float*)(ws + WS_ROPE), QSCALE, EPS};
            pg8::gemm_phase<pg8::EpiIn, pg8::Sched, true, true>(F.lds + RING_OFF, g, S, E);
            { constexpr int FI = (MT / 256 * (DIN / 256)) % 256, Q = (256 - FI) * NWAVES * 6;
              if (L <= 1) { FRAME(); CArgs ap2 = get_args();
                  if (L == 0) tail_convert(F, ap2, 1, 0, Q, FI);
                  else tail_convert(F, ap2, 2, 6592, 6592 + Q, FI); } }
            SEAM(pb + 1);
        }
        if (IN(pb + 3)) { FRAME(); CArgs ap = get_args(); bind(F, ap); phase_attn(F, ap, L); SEAM(pb + 3); }
        if (IN(pb + 5)) {
            FRAME(); CArgs ap = get_args(); unsigned char* ws = ap->ws;
            { pg8::Gemm g{(const bf16*)(ws + WS_YC), (const bf16*)(ws + WS_WOUT) + (size_t)L * 1024 * 1024, 1024, 1024, nullptr}; pg8::Sched S; S.init(ML / 256, 4, F.G, F.bid);
              pg8::EpiRes<0> E{(bf16*)(ws + WS_HB), (const float*)(ws + WS_MODS) + (size_t)L * 5 * 6144 + 2 * 1024, nullptr, 4};
              pg8::gemm_phase<pg8::EpiRes<0>, pg8::Sched, true, true>(F.lds + RING_OFF, g, S, E); }
            if (!last) {
                pg8::Gemm g{(const bf16*)(ws + WS_YC), (const bf16*)(ws + WS_WOUT) + (size_t)L * 1024 * 1024, 256, 1024, nullptr}; pg8::Sched S; S.init(4, 4, F.G, F.bid); S.split = 4; S.nwg = 64; S.kp2 = 512;
                pg8::EpiPart E{ap->out};
                pg8::gemm_phase<pg8::EpiPart, pg8::Sched, true, true>(F.lds + RING_OFF, g, S, E); }
            SEAM(pb + 5);
        }
        if (IN(pb + 6)) { FRAME(); CArgs ap = get_args(); bind(F, ap); if (moe) phase_norm2_moe(F, ap, L); else phase_norm2_dense(F, ap, L); SEAM(pb + 6); }
        if (moe && IN(pb + 7)) { FRAME(); CArgs ap = get_args(); bind(F, ap); phase_slots(F, L); SEAM(pb + 7); }
        if (IN(pb + 8)) {
            FRAME(); CArgs ap = get_args(); unsigned char* ws = ap->ws;
            if (!moe) {
                pg8::Gemm g{(const bf16*)(ws + WS_R0), (const bf16*)(ws + WS_W13D) + (size_t)(L >> 1) * 2 * DFF * 1024, 1024, 1024, nullptr};
                pg8::Sched S; S.init(MT / 256, 22, F.G, F.bid);
                pg8::EpiSwiGLU E{(bf16*)(ws + WS_U), DFF, 22};
                pg8::gemm_phase<pg8::EpiSwiGLU, pg8::Sched, true, true>(F.lds + RING_OFF, g, S, E);
                { constexpr int FI = (MT / 256 * 22) % 256;
                  if (L == 0) { FRAME(); CArgs ap2 = get_args(); tail_convert(F, ap2, 1, 4416, CONV_N1, FI); tail_convert(F, ap2, 2, 0, 6592, FI); } }
            } else {
                const int* pst = (const int*)(ws + WS_MOE + MOE_PST);
                pg8::Gemm g{(const bf16*)(ws + WS_R0), (const bf16*)(ws + WS_W13E) + (size_t)(L >> 1) * 8 * 2 * DFE * 1024, 1024, 1024, (const int*)(ws + WS_MOE + MOE_TOK)};
                pg8::Sched S; S.init(pst[8], 11, F.G, F.bid); S.moe = 1;
#pragma unroll
                for (int j = 0; j < 8; ++j) S.ps[j] = pst[j];
                pg8::EpiSwiGLU E{(bf16*)(ws + WS_U), DFE, 11};
                pg8::gemm_phase<pg8::EpiSwiGLU, pg8::Sched, true, true, true>(F.lds + RING_OFF, g, S, E);
            }
            SEAM(pb + 8);
        }
        if (IN(pb + 9)) {
            FRAME(); CArgs ap = get_args(); unsigned char* ws = ap->ws;
            if (!moe) {
                pg8::Gemm g{(const bf16*)(ws + WS_U), (const bf16*)(ws + WS_W2D) + (size_t)(L >> 1) * 1024 * DFF, DFF, DFF, nullptr};
                pg8::Sched S; S.init(ML / 256, 4, F.G, F.bid);
                pg8::EpiRes<0> E{(bf16*)(ws + WS_HB), (const float*)(ws + WS_MODS) + (size_t)L * 5 * 6144 + 5 * 1024, nullptr, 4};
                pg8::gemm_phase<pg8::EpiRes<0>, pg8::Sched, true, true>(F.lds + RING_OFF, g, S, E);
                { pg8::Gemm g2{(const bf16*)(ws + WS_U), (const bf16*)(ws + WS_W2D) + (size_t)(L >> 1) * 1024 * DFF, 256, DFF, nullptr}; pg8::Sched S2; S2.init(4, 4, F.G, F.bid); S2.split = 11; S2.nwg = 176; S2.kp2 = 512;
                  pg8::EpiPart E2{ap->out};
                  pg8::gemm_phase<pg8::EpiPart, pg8::Sched, true, true>(F.lds + RING_OFF, g2, S2, E2); }
            } else {
                const int* pst = (const int*)(ws + WS_MOE + MOE_PST);
                pg8::Gemm g{(const bf16*)(ws + WS_U), (const bf16*)(ws + WS_W2E) + (size_t)(L >> 1) * 8 * 1024 * DFE, DFE, DFE, nullptr};
                const int nfull = (pst[8] * 4) / 256 * 256, ntail = pst[8] * 4 - nfull;
                { pg8::Sched S; S.init(pst[8], 4, F.G, F.bid); S.moe = 1; if (ntail * 4 <= 256) S.nwg = nfull;
#pragma unroll
                  for (int j = 0; j < 8; ++j) S.ps[j] = pst[j];
                  pg8::EpiRes<1> E{nullptr, nullptr, (bf16*)(ws + WS_R0), 4};
                  pg8::gemm_phase<pg8::EpiRes<1>, pg8::Sched, true, true>(F.lds + RING_OFF, g, S, E); }
                if (ntail > 0 && ntail * 4 <= 256) { pg8::SchedT T; T.init(pst[8], 4, F.G, F.bid); T.moe = 1; T.nfull = nfull; T.npiece = ntail * 4; T.tsplit = 4;
#pragma unroll
                  for (int j = 0; j < 8; ++j) T.ps[j] = pst[j];
                  pg8::EpiRes<2> E2{nullptr, nullptr, (bf16*)(ws + WS_R0), 4};
                  pg8::gemm_phase<pg8::EpiRes<2>, pg8::SchedT, true, true>(F.lds + RING_OFF, g, T, E2); }
            }
            SEAM(pb + 9);
        }
    }
    if (IN(NPH - 1)) { FRAME(); CArgs ap = get_args(); bind(F, ap); phase_final(F, ap); }
#undef IN
#undef SEAM
}

extern "C" void kernel_launch(void* const* d_in, const int* in_sizes, int n_in, void* d_out, int out_size, void* d_ws, size_t ws_size, hipStream_t stream) {
    static int ready = 0;
    if (ready == 0) {
        if (n_in != 23 || out_size != ML * D || ws_size < WS_END) { fprintf(stderr, "kernel_launch: unexpected shapes (n_in %d, out %d, ws %zu)\n", n_in, out_size, ws_size); ready = -1; return; }
        if (hipFuncSetAttribute((const void*)fwd, hipFuncAttributeMaxDynamicSharedMemorySize, LDS_BYTES) != hipSuccess) { fprintf(stderr, "kernel_launch: hipFuncSetAttribute failed\n"); ready = -1; return; }
        ready = 1;
    }
    if (ready < 0) return;
    (void)hipMemsetAsync((char*)d_ws + WS_CTL, 0, CTL_ZERO_BYTES, stream);
#ifdef DBG_POISON
    (void)hipMemsetAsync((char*)d_ws + MiB, 0xFF, WS_END - MiB, stream);
    (void)hipMemsetAsync(d_out, 0xFF, (size_t)ML * D * 4, stream);
#endif
    Args a{};
    for (int i = 0; i < 23; ++i) a.in[i] = (const float*)d_in[i];
    a.out = (float*)d_out; a.ws = (unsigned char*)d_ws;
#if MK_SINGLE
    a.ph_lo = 0; a.ph_hi = NPH;
    hipLaunchKernelGGL(fwd, dim3(256), dim3(NTHR), LDS_BYTES, stream, a);
#else
#ifndef DBG_MAXPH
#define DBG_MAXPH NPH
#endif
    for (int p = 0; p < DBG_MAXPH; ++p) {
        if (p >= 1 && p < NPH - 1) { const int L = (p - 1) / 10, q = (p - 1) % 10; if ((q == 7 && !(L & 1)) || q == 2 || q == 4) continue; }
        a.ph_lo = p; a.ph_hi = p + 1;
        hipLaunchKernelGGL(fwd, dim3(256), dim3(NTHR), LDS_BYTES, stream, a);
    }
#endif
}
```

```cpp
#include <hip/hip_runtime.h>
#include <cstdio>
#include <cstdint>
#ifndef MK_SINGLE
#define MK_SINGLE 1
#endif
namespace pg8 {
#define PG8_LAS __attribute__((address_space(3)))
typedef unsigned short bf16_t;
typedef short bf16x8 __attribute__((ext_vector_type(8)));
typedef float f32x4 __attribute__((ext_vector_type(4)));
typedef unsigned u32x4 __attribute__((ext_vector_type(4)));
constexpr int BM = 256, BK = 64, HALF = 128, HTB = HALF * BK * 2  , STAGE_BYTES = 8 * HTB, NXCD = 8, WGM = 8;

__host__ __device__ __forceinline__ int lds_byte(int r, int c) { const int st = (r >> 4) * 2 + (c >> 5), rr = r & 15, cc = c & 31, ob = rr * 64 + cc * 2; return st * 1024 + (ob ^ (((ob >> 9) & 1) << 5)); }
__host__ __device__ __forceinline__ void stage_rc(int b, int& R, int& C) { const int st = b / 1024, sb = b % 1024, swz = sb ^ (((sb >> 9) & 1) << 5); R = (st >> 1) * 16 + swz / 64; C = (st & 1) * 32 + (swz % 64) / 2; }
__host__ __device__ __forceinline__ int perm32(int rho) { const int n = rho >> 4, i = rho & 15; return 8 * (i >> 2) + 4 * n + (i & 3); }

struct Unit { int pm, pn, kofs, ks, hm; };
struct Gemm { const bf16_t* A; const bf16_t* Bt; int K; int ld; const int* tok; };

struct Sched {
    static constexpr bool TAIL = false;
    int nM, nN, nwg, G, c, moe, split, kp2; int ps[8];
    __device__ __forceinline__ void init(int nM_, int nN_, int G_, int c_) { nM = nM_; nN = nN_; nwg = nM * nN; G = G_; c = c_; moe = 0; split = 0; kp2 = 0;
#pragma unroll
        for (int j = 0; j < 8; ++j) ps[j] = 0; }
    __device__ __forceinline__ bool next(int i, Unit& u) const {
        const long L = (long)i * G + c; if (L >= nwg) return false;
        u.hm = 15;
        if (split) { const int ks = (int)L % split, t = (int)L / split; u.pm = 128 + t / nN; u.pn = t % nN; u.ks = ks; u.kofs = ks * kp2; return true; }
        int wgid = (int)L; { const int q = nwg / NXCD, r = nwg % NXCD, xcd = wgid % NXCD, off = wgid / NXCD; wgid = (xcd < r ? xcd * (q + 1) : r * (q + 1) + (xcd - r) * q) + off; }
        const int nig = WGM * nN, gid = wgid / nig, fm = gid * WGM, gsz = (nM - fm) < WGM ? (nM - fm) : WGM;
        const int pm = fm + ((wgid % nig) % gsz), n = (wgid % nig) / gsz;
        int e = 0;
        if (moe) {
#pragma unroll
            for (int j = 1; j < 8; ++j) e += (pm >= ps[j]) ? 1 : 0; }
        u.pm = pm; u.pn = e * nN + n; u.kofs = 0; u.ks = 0; return true;
    }
    __device__ __forceinline__ void a_ready(const Unit&) const {}
    __device__ __forceinline__ void done(const Unit&) const {}
};

struct SchedT : Sched {
    static constexpr bool TAIL = true;
    int nfull, npiece, tsplit;
    __device__ __forceinline__ bool next(int i, Unit& u) const {
        if (i > 0 || c >= npiece) return false;
        const int wgid = nfull + c / tsplit, q = c % tsplit;
        const int nig = WGM * nN, gid = wgid / nig, fm = gid * WGM, gsz = (nM - fm) < WGM ? (nM - fm) : WGM;
        const int pm = fm + ((wgid % nig) % gsz), n = (wgid % nig) / gsz;
        int e = 0;
        if (moe) {
#pragma unroll
            for (int j = 1; j < 8; ++j) e += (pm >= ps[j]) ? 1 : 0; }
        u.pm = pm; u.pn = e * nN + n; u.kofs = 0; u.ks = 0; u.hm = (tsplit == 4) ? (1 << q) : (q ? 12 : 3); return true;
    }
};
__device__ __forceinline__ unsigned cvt_pk_bf16(float lo, float hi) { unsigned r; asm volatile("v_cvt_pk_bf16_f32 %0, %1, %2" : "=v"(r) : "v"(lo), "v"(hi)); return r; }

struct EpiStoreBf16 {
    static constexpr bool PERM = true, AFTER_DRAIN = false;
    bf16_t* O; int ldc; int ntn;
    __device__ __forceinline__ void operator()(const f32x4 (&acc)[2][2][4][2], const Unit& u, int wr, int wc, int fr, int fq) const {
        const int row0 = u.pm * BM + wr * 64 + fr; const int col0 = (u.pn % ntn) * BM + wc * 32 + 8 * fq;
#pragma unroll
        for (int ai = 0; ai < 2; ++ai)
#pragma unroll
            for (int m = 0; m < 4; ++m) { bf16_t* rowp = O + (size_t)(row0 + ai * HALF + m * 16) * ldc + col0;
#pragma unroll
                for (int bj = 0; bj < 2; ++bj) { const f32x4 v0 = acc[ai][bj][m][0], v1 = acc[ai][bj][m][1];
                    u32x4 w; w.x = cvt_pk_bf16(v0[0], v0[1]); w.y = cvt_pk_bf16(v0[2], v0[3]); w.z = cvt_pk_bf16(v1[0], v1[1]); w.w = cvt_pk_bf16(v1[2], v1[3]);
                    *(u32x4*)(rowp + bj * HALF) = w; } }
    }
};
struct EpiIn {
    static constexpr bool PERM = true, AFTER_DRAIN = false;
    bf16_t* O; const float* qg; const float* kg; const float* rope; float qscale; float eps;
    __device__ __forceinline__ void operator()(const f32x4 (&acc)[2][2][4][2], const Unit& u, int wr, int wc, int fr_in, int fq_in) const {
        (void)fr_in; (void)fq_in; int t_ = threadIdx.x; asm volatile("" : "+v"(t_)); const int fr = t_ & 15, fq = (t_ >> 4) & 3;
        const int row0 = u.pm * BM + wr * 64 + fr; const int col0 = u.pn * BM + wc * 32 + 8 * fq; constexpr int ldc = 2304;
        const bool isq = (u.pn == 6 || u.pn == 7), isk = (u.pn == 8 && wc < 2);
        if (u.pn >= 2 && u.pn <= 5) {
            const int cu0 = 512 + (u.pn - 2) * HALF + wc * 32 + 8 * fq;
#pragma unroll
            for (int ai = 0; ai < 2; ++ai)
#pragma unroll
                for (int m = 0; m < 4; ++m) { const f32x4 a0 = acc[ai][0][m][0] * acc[ai][1][m][0], a1 = acc[ai][0][m][1] * acc[ai][1][m][1];
                    u32x4 w; w.x = cvt_pk_bf16(a0[0], a0[1]); w.y = cvt_pk_bf16(a0[2], a0[3]); w.z = cvt_pk_bf16(a1[0], a1[1]); w.w = cvt_pk_bf16(a1[2], a1[3]);
                    *(u32x4*)(O + (size_t)(row0 + ai * HALF + m * 16) * ldc + cu0) = w; }
            return;
        }
        if (!(isq || isk)) {
#pragma unroll
            for (int ai = 0; ai < 2; ++ai)
#pragma unroll
                for (int m = 0; m < 4; ++m) { bf16_t* rowp = O + (size_t)(row0 + ai * HALF + m * 16) * ldc + col0;
#pragma unroll
                    for (int bj = 0; bj < 2; ++bj) { const f32x4 v0 = acc[ai][bj][m][0], v1 = acc[ai][bj][m][1];
                        u32x4 w; w.x = cvt_pk_bf16(v0[0], v0[1]); w.y = cvt_pk_bf16(v0[2], v0[3]); w.z = cvt_pk_bf16(v1[0], v1[1]); w.w = cvt_pk_bf16(v1[2], v1[3]);
                        *(u32x4*)(rowp + bj * HALF) = w; } }
            return;
        }
        const float* gp = isq ? qg : kg; const float sc = isq ? qscale : 1.0f; const bool lat = u.pm < 128;
        f32x4 gn[2][2];
#pragma unroll
        for (int bj = 0; bj < 2; ++bj)
#pragma unroll
            for (int n = 0; n < 2; ++n) gn[bj][n] = *(const f32x4*)(gp + 32 * bj + 16 * n + 4 * fq) * sc;
        u32x4 w[4][2];
        f32x4 rn[2][2] = {};
        const int ln = fq * 16 + fr;
#define EPIIN_ROPE(g, r) do { const int t_ = (row0 + ((g) >> 2) * HALF + ((g) & 3) * 16) & 8191; _Pragma("unroll") for (int bj = 0; bj < 2; ++bj) { const int pos_ = bj ? (t_ & 63) : (t_ >> 6); \
            const float* p_ = rope + (size_t)(pos_ * 16 + 4 * fq) * 2; r[bj][0] = *(const f32x4*)p_; r[bj][1] = *(const f32x4*)(p_ + 4); } } while (0)
        if (lat) EPIIN_ROPE(0, rn);
#pragma unroll
        for (int ai = 0; ai < 2; ++ai) {
            float rinv[4];
#pragma unroll
            for (int m = 0; m < 4; ++m) { float ss = 0.f;
#pragma unroll
                for (int bj = 0; bj < 2; ++bj)
#pragma unroll
                    for (int n = 0; n < 2; ++n) { const f32x4 x = acc[ai][bj][m][n]; ss += (x[0] * x[0] + x[1] * x[1]) + (x[2] * x[2] + x[3] * x[3]); }
                rinv[m] = ss; }
#pragma unroll
            for (int m = 0; m < 4; ++m) rinv[m] += __int_as_float(__builtin_amdgcn_ds_bpermute((ln ^ 16) << 2, __float_as_int(rinv[m])));
#pragma unroll
            for (int m = 0; m < 4; ++m) rinv[m] += __int_as_float(__builtin_amdgcn_ds_bpermute((ln ^ 32) << 2, __float_as_int(rinv[m])));
#pragma unroll
            for (int m = 0; m < 4; ++m) rinv[m] = __builtin_amdgcn_rsqf(rinv[m] * (1.0f / 64.0f) + eps);
#pragma unroll
            for (int m = 0; m < 4; ++m) { const int g = ai * 4 + m;
                f32x4 rc[2][2];
#pragma unroll
                for (int bj = 0; bj < 2; ++bj) { rc[bj][0] = rn[bj][0]; rc[bj][1] = rn[bj][1]; }
                if (lat && g < 7) EPIIN_ROPE(g + 1, rn);
#pragma unroll
                for (int bj = 0; bj < 2; ++bj) { f32x4 y0 = acc[ai][bj][m][0] * rinv[m] * gn[bj][0], y1 = acc[ai][bj][m][1] * rinv[m] * gn[bj][1];
                    if (lat) { const f32x4 ca = rc[bj][0], cb = rc[bj][1];
                        const f32x4 c = {ca[0], ca[2], cb[0], cb[2]}, sn = {ca[1], ca[3], cb[1], cb[3]};
                        const f32x4 o0 = y0 * c - y1 * sn, o1 = y1 * c + y0 * sn; y0 = o0; y1 = o1; }
                    w[m][bj].x = cvt_pk_bf16(y0[0], y0[1]); w[m][bj].y = cvt_pk_bf16(y0[2], y0[3]); w[m][bj].z = cvt_pk_bf16(y1[0], y1[1]); w[m][bj].w = cvt_pk_bf16(y1[2], y1[3]); } }
#pragma unroll
            for (int mm = 0; mm < 4; ++mm) { bf16_t* rowp = O + (size_t)(row0 + ai * HALF + mm * 16) * ldc + col0;
#pragma unroll
                for (int bj = 0; bj < 2; ++bj) *(u32x4*)(rowp + bj * HALF) = w[mm][bj]; }
        }
#undef EPIIN_ROPE
    }
};
struct EpiPart {
    static constexpr bool PERM = false, AFTER_DRAIN = false;
    float* P;
    __device__ __forceinline__ void operator()(const f32x4 (&acc)[2][2][4][2], const Unit& u, int wr, int wc, int fr, int fq) const {
        float* pb = P + (size_t)u.ks * 1024 * 1024 + (size_t)((u.pm - 128) * BM + wr * 64 + fr) * 1024 + u.pn * BM + wc * 32 + 4 * fq;
#pragma unroll
        for (int ai = 0; ai < 2; ++ai)
#pragma unroll
            for (int m = 0; m < 4; ++m)
#pragma unroll
                for (int bj = 0; bj < 2; ++bj)
#pragma unroll
                    for (int n = 0; n < 2; ++n) *(f32x4*)(pb + (size_t)(ai * HALF + m * 16) * 1024 + bj * HALF + n * 16) = acc[ai][bj][m][n];
    }
};
__device__ __forceinline__ float silu_f(float x) { return x * __builtin_amdgcn_rcpf(1.0f + __builtin_amdgcn_exp2f(-1.4426950408889634f * x)); }
struct EpiSwiGLU {
    static constexpr bool PERM = true, AFTER_DRAIN = false;
    bf16_t* O; int ldc; int ntn;
    __device__ __forceinline__ void operator()(const f32x4 (&acc)[2][2][4][2], const Unit& u, int wr, int wc, int fr, int fq) const {
        const int row0 = u.pm * BM + wr * 64 + fr; const int col0 = (u.pn % ntn) * HALF + wc * 32 + 8 * fq;
#pragma unroll
        for (int ai = 0; ai < 2; ++ai)
#pragma unroll
            for (int m = 0; m < 4; ++m) { bf16_t* rowp = O + (size_t)(row0 + ai * HALF + m * 16) * ldc + col0;
                const f32x4 g0 = acc[ai][0][m][0], g1 = acc[ai][0][m][1], a0 = acc[ai][1][m][0], a1 = acc[ai][1][m][1];
                f32x4 d0, d1;
#pragma unroll
                for (int i = 0; i < 4; ++i) { d0[i] = __builtin_amdgcn_exp2f(g0[i]); d1[i] = __builtin_amdgcn_exp2f(g1[i]); }
                d0 = d0 + 1.0f; d1 = d1 + 1.0f;
                f32x4 r0, r1;
#pragma unroll
                for (int i = 0; i < 4; ++i) { r0[i] = __builtin_amdgcn_rcpf(d0[i]); r1[i] = __builtin_amdgcn_rcpf(d1[i]); }
                const f32x4 o0 = (g0 * a0) * r0, o1 = (g1 * a1) * r1;
                u32x4 w; w.x = cvt_pk_bf16(o0[0], o0[1]); w.y = cvt_pk_bf16(o0[2], o0[3]); w.z = cvt_pk_bf16(o1[0], o1[1]); w.w = cvt_pk_bf16(o1[2], o1[3]);
                *(u32x4*)rowp = w; }
    }
};
template <int MODE> struct EpiRes {
    static constexpr bool PERM = true, AFTER_DRAIN = false;
    bf16_t* hl; const float* gate; bf16_t* Y; int ntn;
    __device__ __forceinline__ void operator()(const f32x4 (&acc)[2][2][4][2], const Unit& u, int wr, int wc, int fr, int fq) const {
        const int r0 = wr * 64 + fr; const int colp = (u.pn % ntn) * BM + wc * 32 + 8 * fq;
        if constexpr (MODE == 0) {
            bf16_t* hb = hl + (size_t)(u.pm * BM + r0) * 1024 + colp;
            const float* gp = gate + (size_t)(u.pm >> 5) * 6144 + colp;
            u32x4 hv[2][2][4];
#pragma unroll
            for (int bj = 0; bj < 2; ++bj)
#pragma unroll
                for (int ai = 0; ai < 2; ++ai)
#pragma unroll
                    for (int m = 0; m < 4; ++m) hv[bj][ai][m] = *(const u32x4*)(hb + (size_t)(ai * HALF + m * 16) * 1024 + bj * HALF);
#pragma unroll
            for (int bj = 0; bj < 2; ++bj) { const f32x4 g0 = *(const f32x4*)(gp + bj * HALF), g1 = *(const f32x4*)(gp + bj * HALF + 4);
#pragma unroll
                for (int ai = 0; ai < 2; ++ai)
#pragma unroll
                    for (int m = 0; m < 4; ++m) { const f32x4 v0 = acc[ai][bj][m][0], v1 = acc[ai][bj][m][1]; const u32x4 h = hv[bj][ai][m];
                        u32x4 w;
                        w.x = cvt_pk_bf16(__builtin_bit_cast(float, h.x << 16) + g0[0] * v0[0], __builtin_bit_cast(float, h.x & 0xffff0000u) + g0[1] * v0[1]);
                        w.y = cvt_pk_bf16(__builtin_bit_cast(float, h.y << 16) + g0[2] * v0[2], __builtin_bit_cast(float, h.y & 0xffff0000u) + g0[3] * v0[3]);
                        w.z = cvt_pk_bf16(__builtin_bit_cast(float, h.z << 16) + g1[0] * v1[0], __builtin_bit_cast(float, h.z & 0xffff0000u) + g1[1] * v1[1]);
                        w.w = cvt_pk_bf16(__builtin_bit_cast(float, h.w << 16) + g1[2] * v1[2], __builtin_bit_cast(float, h.w & 0xffff0000u) + g1[3] * v1[3]);
                        *(u32x4*)(hb + (size_t)(ai * HALF + m * 16) * 1024 + bj * HALF) = w; } }
        } else {
            bf16_t* yb = Y + (size_t)(u.pm * BM + r0) * 1024 + colp;
#pragma unroll
            for (int ai = 0; ai < 2; ++ai)
#pragma unroll
                for (int m = 0; m < 4; ++m)
#pragma unroll
                    for (int bj = 0; bj < 2; ++bj) { if constexpr (MODE == 2) { if (!((u.hm >> (2 * ai + bj)) & 1)) continue; }
                        const f32x4 v0 = acc[ai][bj][m][0], v1 = acc[ai][bj][m][1];
                        u32x4 w; w.x = cvt_pk_bf16(v0[0], v0[1]); w.y = cvt_pk_bf16(v0[2], v0[3]); w.z = cvt_pk_bf16(v1[0], v1[1]); w.w = cvt_pk_bf16(v1[2], v1[3]);
                        *(u32x4*)(yb + (size_t)(ai * HALF + m * 16) * 1024 + bj * HALF) = w; }
        }
    }
};

template <class Epi, class Sched, bool ALIGN_EPI = false, bool SP2 = false, bool GATHER = false  >
__device__ __forceinline__ void gemm_phase(PG8_LAS unsigned char* lds, const Gemm g, const Sched& S, const Epi& E) {
    int tid_l = threadIdx.x; asm volatile("" : "+v"(tid_l));
    const int tid = tid_l, wid = __builtin_amdgcn_readfirstlane(tid >> 6), lane = tid & 63, wr = wid >> 2, wc = wid & 3, fr = lane & 15, fq = lane >> 4;
    const int K = g.K, nt = K / BK, LD = g.ld;
    unsigned voffA[2], voffB[2];
#pragma unroll
    for (int i = 0; i < 2; ++i) { int R, C; stage_rc(tid * 16 + i * 8192, R, C); const int Rb = Epi::PERM ? ((R & ~31) + perm32(R & 31)) : R;
        voffA[i] = (unsigned)(R * LD + C) * 2u; voffB[i] = (unsigned)(Rb * LD + C) * 2u; }
    const size_t kstep = (size_t)(BK * 2);
    const size_t hstep = (size_t)HALF * LD * 2;
    const size_t tstep = 2 * hstep;
    const unsigned ldsw = (unsigned)wid * 1024u;
    const int aoff = lds_byte(wr * 64 + fr, fq * 8), boff = lds_byte(wc * 32 + fr, fq * 8);
#define PG8_SA(b, h) (((b) * 2 + (h)) * HTB)
#define PG8_SB(b, h) ((4 + (b) * 2 + (h)) * HTB)
#define PG8_STAGE(bufoff, gbase, voff) do { _Pragma("unroll") for (int _i = 0; _i < 2; ++_i) \
        __builtin_amdgcn_global_load_lds((const unsigned*)((const char*)(gbase) + (voff)[_i]), (PG8_LAS unsigned*)(lds + (bufoff) + ldsw + _i * 8192), 16, 0, 0); } while (0)
#define PG8_STAGE_A(b, h, ptr, NX) do { if constexpr (GATHER) { _Pragma("unroll") for (int _i = 0; _i < 2; ++_i) \
        __builtin_amdgcn_global_load_lds((const unsigned*)((const char*)(ptr) + ((((NX) ? pkn[h] : pkc[h]) >> (16 * _i)) & 0xffffu) * (unsigned)(LD * 2) + gcol), (PG8_LAS unsigned*)(lds + PG8_SA(b, h) + ldsw + _i * 8192), 16, 0, 0); } \
        else { PG8_STAGE(PG8_SA(b, h), (ptr) + (h) * hstep, voffA); } } while (0)
#define PG8_LDA(dst, b, h) do { _Pragma("unroll") for (int m = 0; m < 4; ++m) _Pragma("unroll") for (int k = 0; k < 2; ++k) dst[m][k] = *(const PG8_LAS bf16x8*)(lds + PG8_SA(b, h) + aoff + m * 2048 + k * 1024); } while (0)
#define PG8_LDB(dst, b, h) do { _Pragma("unroll") for (int n = 0; n < 2; ++n) _Pragma("unroll") for (int k = 0; k < 2; ++k) dst[n][k] = *(const PG8_LAS bf16x8*)(lds + PG8_SB(b, h) + boff + n * 2048 + k * 1024); } while (0)
#define PG8_MMA(ai, bj, At, Bt) do { __builtin_amdgcn_s_setprio(1); _Pragma("unroll") for (int m = 0; m < 4; ++m) _Pragma("unroll") for (int n = 0; n < 2; ++n) _Pragma("unroll") for (int k = 0; k < 2; ++k) \
        acc[ai][bj][m][n] = __builtin_amdgcn_mfma_f32_16x16x32_bf16(Bt[n][k], At[m][k], acc[ai][bj][m][n], 0, 0, 0); __builtin_amdgcn_s_setprio(0); } while (0)
#define PG8_MMAG(ai, bj, At, Bt) do { if constexpr (Sched::TAIL) { if ((cur.hm >> (2 * (ai) + (bj))) & 1) PG8_MMA(ai, bj, At, Bt); } else PG8_MMA(ai, bj, At, Bt); } while (0)
#define PG8_WAIT_V(n) asm volatile("s_waitcnt vmcnt(" #n ")" ::: "memory")
#define PG8_WAIT_L(n) asm volatile("s_waitcnt lgkmcnt(" #n ")" ::: "memory")
#define PG8_BAR __builtin_amdgcn_s_barrier()
#define PG8_SCHED __builtin_amdgcn_sched_barrier(0)
    Unit cur, nxt; int ui = 0;
    if (!S.next(0, cur)) return;
    f32x4 acc[2][2][4][2];
#pragma unroll
    for (int a = 0; a < 2; ++a)
#pragma unroll
        for (int b = 0; b < 2; ++b)
#pragma unroll
            for (int m = 0; m < 4; ++m)
#pragma unroll
                for (int n = 0; n < 2; ++n) acc[a][b][m][n] = (f32x4){0.f, 0.f, 0.f, 0.f};
    bf16x8 At[4][2], B0[2][2], B1[2][2];
    const char* cA = (const char*)g.A + (GATHER ? (size_t)0 : (size_t)cur.pm * tstep) + cur.kofs; const char* cB = (const char*)g.Bt + (size_t)cur.pn * tstep + cur.kofs;
    unsigned pkc[2], pkn[2], gcol = 0;
#define PG8_GATHER(pk, u) do { _Pragma("unroll") for (int h_ = 0; h_ < 2; ++h_) { int R_, C_; stage_rc(tid * 16, R_, C_);          \
        const unsigned t0_ = (unsigned)g.tok[(u).pm * BM + h_ * HALF + R_], t1_ = (unsigned)g.tok[(u).pm * BM + h_ * HALF + R_ + 64]; pk[h_] = t0_ | (t1_ << 16); } } while (0)
    if constexpr (GATHER) { { int R_, C_; stage_rc(tid * 16, R_, C_); gcol = (unsigned)C_ * 2u; } PG8_GATHER(pkc, cur); pkn[0] = pkc[0]; pkn[1] = pkc[1]; }
    S.a_ready(cur);
    if constexpr (SP2) {
        PG8_STAGE(PG8_SB(0, 0), cB, voffB); PG8_STAGE(PG8_SB(0, 1), cB + hstep, voffB); PG8_STAGE_A(0, 0, cA, false); PG8_STAGE_A(0, 1, cA, false);
        if (wr == 1) PG8_BAR;
        PG8_WAIT_V(2); PG8_BAR;
        PG8_STAGE(PG8_SB(1, 0), cB + kstep, voffB); PG8_STAGE_A(1, 0, cA + kstep, false); PG8_STAGE(PG8_SB(1, 1), cB + hstep + kstep, voffB);
        PG8_WAIT_V(6); PG8_BAR;
    } else {
        PG8_STAGE(PG8_SB(0, 0), cB, voffB); PG8_STAGE_A(0, 0, cA, false); PG8_STAGE(PG8_SB(0, 1), cB + hstep, voffB); PG8_STAGE_A(0, 1, cA, false);
        if (wr == 1) PG8_BAR;
        PG8_WAIT_V(4); PG8_BAR;
        PG8_STAGE(PG8_SB(1, 0), cB + kstep, voffB); PG8_STAGE_A(1, 0, cA + kstep, false); PG8_STAGE(PG8_SB(1, 1), cB + hstep + kstep, voffB);
        PG8_WAIT_V(6); PG8_BAR;
    }
    for (;;) {
        const bool has_next = S.next(ui + 1, nxt);
        if constexpr (GATHER) { if (has_next) PG8_GATHER(pkn, nxt); }
        const char* nA = has_next ? (const char*)g.A + (GATHER ? (size_t)0 : (size_t)nxt.pm * tstep) + nxt.kofs : cA; const char* nB = has_next ? (const char*)g.Bt + (size_t)nxt.pn * tstep + nxt.kofs : cB;
        for (int t = 0; t < nt; t += 2) {
            const bool last = (t == nt - 2);
            const char* a1 = cA + (size_t)(t + 1) * kstep;
            const char* a2 = last ? nA : cA + (size_t)(t + 2) * kstep; const char* b2 = last ? nB : cB + (size_t)(t + 2) * kstep;
            const char* a3 = a2 + kstep; const char* b3 = b2 + kstep;
            if (last && has_next) S.a_ready(nxt);
            if constexpr (SP2) {
            PG8_LDB(B0, 0, 0); PG8_LDB(B1, 0, 1); PG8_SCHED; PG8_LDA(At, 0, 0); PG8_STAGE_A(1, 1, a1, false);
            PG8_WAIT_V(8); PG8_WAIT_L(0); PG8_BAR; PG8_MMAG(0, 0, At, B0); PG8_MMAG(0, 1, At, B1); PG8_BAR; PG8_SCHED;
            PG8_LDA(At, 0, 1); PG8_STAGE(PG8_SB(0, 0), b2, voffB); PG8_STAGE(PG8_SB(0, 1), b2 + hstep, voffB); PG8_STAGE_A(0, 0, a2, last);
            PG8_WAIT_V(8); PG8_WAIT_L(0); PG8_BAR; PG8_MMAG(1, 0, At, B0); PG8_MMAG(1, 1, At, B1); PG8_BAR; PG8_SCHED;
            PG8_LDB(B0, 1, 0); PG8_LDB(B1, 1, 1); PG8_SCHED; PG8_LDA(At, 1, 0); PG8_STAGE_A(0, 1, a2, last);
            PG8_WAIT_V(8); PG8_WAIT_L(0); PG8_BAR; PG8_MMAG(0, 0, At, B0); PG8_MMAG(0, 1, At, B1); PG8_BAR; PG8_SCHED;
            PG8_LDA(At, 1, 1); PG8_STAGE(PG8_SB(1, 0), b3, voffB); PG8_STAGE(PG8_SB(1, 1), b3 + hstep, voffB); PG8_STAGE_A(1, 0, a3, last);
            PG8_WAIT_V(8); PG8_WAIT_L(0); PG8_BAR; PG8_MMAG(1, 0, At, B0); PG8_MMAG(1, 1, At, B1); PG8_BAR; PG8_SCHED;
            } else {
            PG8_LDB(B0, 0, 0); PG8_SCHED; PG8_LDA(At, 0, 0); PG8_STAGE_A(1, 1, a1, false);
            PG8_WAIT_L(8); PG8_BAR; PG8_WAIT_L(0); PG8_MMA(0, 0, At, B0); PG8_BAR; PG8_SCHED;
            PG8_LDB(B1, 0, 1); PG8_STAGE(PG8_SB(0, 0), b2, voffB);
            PG8_BAR; PG8_WAIT_L(0); PG8_MMA(0, 1, At, B1); PG8_BAR;
            PG8_LDA(At, 0, 1); PG8_STAGE_A(0, 0, a2, last);
            PG8_BAR; PG8_WAIT_L(0); PG8_MMA(1, 0, At, B0); PG8_BAR; PG8_SCHED;
            PG8_STAGE(PG8_SB(0, 1), b2 + hstep, voffB);
            PG8_WAIT_V(6); PG8_BAR; PG8_MMA(1, 1, At, B1); PG8_BAR;
            PG8_LDB(B0, 1, 0); PG8_SCHED; PG8_LDA(At, 1, 0); PG8_STAGE_A(0, 1, a2, last);
            PG8_WAIT_L(8); PG8_BAR; PG8_WAIT_L(0); PG8_MMA(0, 0, At, B0); PG8_BAR; PG8_SCHED;
            PG8_LDB(B1, 1, 1); PG8_STAGE(PG8_SB(1, 0), b3, voffB);
            PG8_BAR; PG8_WAIT_L(0); PG8_MMA(0, 1, At, B1); PG8_BAR;
            PG8_LDA(At, 1, 1); PG8_STAGE_A(1, 0, a3, last);
            PG8_BAR; PG8_WAIT_L(0); PG8_MMA(1, 0, At, B0); PG8_BAR; PG8_SCHED;
            PG8_STAGE(PG8_SB(1, 1), b3 + hstep, voffB);
            PG8_WAIT_V(6); PG8_BAR; PG8_MMA(1, 1, At, B1); PG8_BAR;
            }
        }
        if constexpr (ALIGN_EPI) { if (wr == 0) PG8_BAR; }
        if constexpr (!Epi::AFTER_DRAIN) { E(acc, cur, wr, wc, fr, fq); S.done(cur); }
        if (!has_next) break;
#pragma unroll
        for (int a = 0; a < 2; ++a)
#pragma unroll
            for (int b = 0; b < 2; ++b)
#pragma unroll
                for (int m = 0; m < 4; ++m)
#pragma unroll
                    for (int n = 0; n < 2; ++n) acc[a][b][m][n] = (f32x4){0.f, 0.f, 0.f, 0.f};
        cur = nxt; cA = nA; cB = nB; ++ui;
        if constexpr (GATHER) { pkc[0] = pkn[0]; pkc[1] = pkn[1]; }
        if constexpr (ALIGN_EPI) { if (wr == 1) PG8_BAR; }
    }
    PG8_WAIT_V(0);
    if constexpr (!ALIGN_EPI) { if (wr == 0) PG8_BAR; }
    PG8_BAR;
    if constexpr (Epi::AFTER_DRAIN) { E.fused(acc, cur, wr, wc, fr, fq, lds, wid, lane); S.done(cur); }
#undef PG8_SA
#undef PG8_SB
#undef PG8_STAGE
#undef PG8_STAGE_A
#undef PG8_GATHER
#undef PG8_LDA
#undef PG8_LDB
#undef PG8_MMA
#undef PG8_MMAG
#undef PG8_WAIT_V
#undef PG8_WAIT_L
#undef PG8_BAR
#undef PG8_SCHED
}
}
constexpr int D = 1024, NB = 4, SEQ = 8192, CTXL = 256, NLAYER = 4;
constexpr int ML = NB * SEQ, MC = NB * CTXL, MT = ML + MC;
constexpr int DIN = 2304, DFF = 2816, DFE = 1408, NE = 8;
constexpr int ZQ = 1536, ZK = 2048, ZV = 2176;
constexpr float EPS = 1e-6f, LOG2E = 1.4426950408889634f, QSCALE = 0.125f * 1.4426950408889634f;
constexpr int MAXP = 272;
constexpr size_t MiB = 1u << 20;
constexpr size_t WS_CTL = 0, CTL_ZERO_BYTES = 1 * MiB;
constexpr size_t WS_MODS = 1 * MiB;
constexpr size_t WS_ROPE = 2 * MiB;
constexpr size_t WS_MOE = 3 * MiB;
constexpr size_t MOE_HIST = 0, MOE_PST = 8192, MOE_SEL = 8192 + 256, MOE_GATE = MOE_SEL + (size_t)MT * 4, MOE_SLOT = MOE_GATE + (size_t)MT * 8, MOE_TOK = MOE_SLOT + (size_t)MT * 8;
static_assert(MOE_TOK + (size_t)MAXP * 256 * 4 <= MiB, "moe tables");
constexpr size_t WS_HC = 4 * MiB;
constexpr size_t WS_WIN = 8 * MiB, WS_WOUT = 26 * MiB, WS_W13D = 34 * MiB, WS_W2D = 56 * MiB, WS_W13E = 67 * MiB, WS_W2E = 155 * MiB;
constexpr size_t WS_R0 = 200 * MiB;
constexpr size_t WS_U = 336 * MiB;
constexpr size_t WS_XN = 349 * MiB;
constexpr size_t WS_YC = 415 * MiB;
constexpr size_t WS_HB = 523 * MiB;
constexpr size_t WS_END = 587 * MiB;
static_assert(WS_R0 + (size_t)MT * DIN * 2 <= WS_XN && WS_R0 + (size_t)MAXP * 256 * 1024 * 2 <= WS_U && WS_U + (size_t)MAXP * 256 * DFE * 2 <= WS_HB && WS_U + (size_t)MT * DFF * 2 <= WS_HB && WS_HB + (size_t)ML * D * 2 <= WS_END && (size_t)11 * 4 * MiB <= (size_t)ML * D * 4, "ws map");
static_assert(WS_W2E + (size_t)16 * 1024 * DFE * 2 <= WS_R0, "ws map weights");
constexpr int RING_OFF = 0, RING_BYTES = 131072, LDSCTL_OFF = RING_BYTES, MISC_OFF = LDSCTL_OFF + 320, LDS_BYTES = 147456;
constexpr int NWAVES = 8, NTHR = 512;

#define GAS __attribute__((address_space(1)))
#define LAS __attribute__((address_space(3)))
typedef unsigned short bf16;
typedef unsigned v4u __attribute__((ext_vector_type(4)));
typedef unsigned v2u __attribute__((ext_vector_type(2)));
typedef float f32x4 __attribute__((ext_vector_type(4)));
typedef float f32x2 __attribute__((ext_vector_type(2)));
typedef short bf16x8 __attribute__((ext_vector_type(8)));
typedef GAS unsigned gu32;
#define RLX_AGENT __ATOMIC_RELAXED, __HIP_MEMORY_SCOPE_AGENT
#define LDS_WAIT() asm volatile("s_waitcnt lgkmcnt(0)" ::: "memory")
__device__ __forceinline__ unsigned pk2(float lo, float hi) { typedef __bf16 bf2 __attribute__((ext_vector_type(2))); f32x2 v = {lo, hi}; bf2 b = __builtin_convertvector(v, bf2); return __builtin_bit_cast(unsigned, b); }
__device__ __forceinline__ float bflo(unsigned w) { return __uint_as_float(w << 16); }
__device__ __forceinline__ float bfhi(unsigned w) { return __uint_as_float(w & 0xffff0000u); }
__device__ __forceinline__ float shx(float v, int o, int lane) { return __int_as_float(__builtin_amdgcn_ds_bpermute((lane ^ o) << 2, __float_as_int(v))); }
__device__ __forceinline__ float dpp_add(float v, const int ctrl_sel) {
    const int x = __float_as_int(v);
    const int y = ctrl_sel == 0 ? __builtin_amdgcn_update_dpp(0, x, 0xB1, 0xf, 0xf, true)
                : ctrl_sel == 1 ? __builtin_amdgcn_update_dpp(0, x, 0x4E, 0xf, 0xf, true)
                : ctrl_sel == 2 ? __builtin_amdgcn_update_dpp(0, x, 0x141, 0xf, 0xf, true)
                                : __builtin_amdgcn_update_dpp(0, x, 0x140, 0xf, 0xf, true);
    return v + __int_as_float(y);
}
__device__ __forceinline__ float wave_sum(float v, int lane) {
    (void)lane;
    v = dpp_add(v, 0); v = dpp_add(v, 1); v = dpp_add(v, 2); v = dpp_add(v, 3);
    const int x = __float_as_int(v);
    const float r0 = __int_as_float(__builtin_amdgcn_readlane(x, 0)), r1 = __int_as_float(__builtin_amdgcn_readlane(x, 16)), r2 = __int_as_float(__builtin_amdgcn_readlane(x, 32)), r3 = __int_as_float(__builtin_amdgcn_readlane(x, 48));
    return (r0 + r1) + (r2 + r3);
}
struct Args { const float* in[23]; float* out; unsigned char* ws; int ph_lo, ph_hi; };
#define XB_TMO      128
#define XB_XCNT(j)  (256  + 64 * (j))
#define XB_XSUB(j)  (1280 + 64 * (j))
#define XB_XGEN(j)  (2304 + 64 * (j))
#define XB_TOP      3328
#define XB_TOPGEN   3392
#define XCD_BAR_WORDS 3456
#define XB_SPIN_CAP (1u << 18)

__device__ __forceinline__ unsigned xb_ld(unsigned* p)              { return __hip_atomic_load(p, __ATOMIC_RELAXED, __HIP_MEMORY_SCOPE_AGENT); }
__device__ __forceinline__ unsigned xb_add(unsigned* p, unsigned v) { return __hip_atomic_fetch_add(p, v, __ATOMIC_RELAXED, __HIP_MEMORY_SCOPE_AGENT); }
__device__ __forceinline__ unsigned xb_xcc_id() { return (unsigned)__builtin_amdgcn_s_getreg((3 << 11) | 20) & 0xFu; }
#define XB_SPIN(cond, bar) do { unsigned _sp = 0; while (cond) { __builtin_amdgcn_s_sleep(1); \
    if ((++_sp & 255u) == 0u) { if (xb_ld(&(bar)[XB_TMO])) break; if (_sp > XB_SPIN_CAP) { atomicAdd(&(bar)[XB_TMO], 1u); break; } } } } while (0)

struct XcdBarrier {
    unsigned* bar; unsigned x;
    volatile LAS unsigned* st;
};

__device__ __forceinline__ XcdBarrier xcd_barrier_post(unsigned* bar, volatile LAS unsigned* st) {
    XcdBarrier b; b.bar = bar; b.x = xb_xcc_id(); b.st = st;
    if (threadIdx.x == 0) (void)xb_add(&bar[XB_XCNT(b.x)], 1u);
    return b;
}
__device__ __forceinline__ void xcd_barrier_complete(unsigned* bar, unsigned x, unsigned& nloc, unsigned& nx) {
    const unsigned G = gridDim.x * gridDim.y * gridDim.z;
    unsigned sum, cnt, mine, sp = 0u;
    for (;;) {
        sum = 0u; cnt = 0u; mine = 0u;
#pragma unroll
        for (unsigned j = 0; j < 16; ++j) { const unsigned c = xb_ld(&bar[XB_XCNT(j)]); sum += c; cnt += (c > 0u) ? 1u : 0u; mine = (j == x) ? c : mine; }
        if (sum == G) break;
        __builtin_amdgcn_s_sleep(1);
        if ((++sp & 255u) == 0u) { if (xb_ld(&bar[XB_TMO])) break; if (sp > XB_SPIN_CAP) { atomicAdd(&bar[XB_TMO], 1u); break; } }
    }
    nloc = mine > 0u ? mine : 1u; nx = cnt > 0u ? cnt : 1u;
}

__device__ __forceinline__ void xcd_barrier(const XcdBarrier& b) {
    asm volatile("s_waitcnt vmcnt(0)" ::: "memory");
    __syncthreads();
    if (threadIdx.x == 0) {
        unsigned* bar = b.bar;
        __builtin_amdgcn_s_waitcnt(0);
        unsigned nloc = b.st[0], nx = b.st[1];
        if (nloc == 0u) { xcd_barrier_complete(bar, b.x, nloc, nx); b.st[0] = nloc; b.st[1] = nx; }
        const unsigned old = xb_add(&bar[XB_XSUB(b.x)], 1u);
        const unsigned gen = old / nloc;
        if (old + 1u == (gen + 1u) * nloc) {
            __builtin_amdgcn_fence(__ATOMIC_RELEASE, "agent");
            asm volatile("s_waitcnt vmcnt(0)" ::: "memory");
            const unsigned og = xb_add(&bar[XB_TOP], 1u);
            const unsigned tg = og / nx;
            if (og + 1u == (tg + 1u) * nx) xb_add(&bar[XB_TOPGEN], 1u);
            else XB_SPIN(xb_ld(&bar[XB_TOPGEN]) == tg, bar);
            __builtin_amdgcn_fence(__ATOMIC_ACQUIRE, "agent");
            asm volatile("s_waitcnt vmcnt(0)" ::: "memory");
        } else {
            XB_SPIN(xb_ld(&bar[XB_TOPGEN]) == gen, bar);
            __builtin_amdgcn_fence(__ATOMIC_ACQUIRE, "agent");
            asm volatile("s_waitcnt vmcnt(0)" ::: "memory");
        }
    }
    __syncthreads();
}
typedef const __attribute__((address_space(4))) Args* CArgs;
__device__ __forceinline__ CArgs get_args() { CArgs p = (CArgs)__builtin_amdgcn_kernarg_segment_ptr(); asm volatile("" : "+s"(p)); return p; }
struct Frame {
    LAS unsigned char* lds;
    int tid, lane, wave, G, bid, gw, NGW;
    float* out; float* mods; f32x2* rope; float* hc; bf16* hb;
    bf16 *Z, *XG, *U, *XN, *YC;
    int* hist; int* pst; int* sel; f32x2* gates; int* slots; int* tok;
};
__device__ __forceinline__ void bind(Frame& F, CArgs ap) {
    unsigned char* ws = ap->ws; F.out = ap->out;
    F.mods = (float*)(ws + WS_MODS); F.rope = (f32x2*)(ws + WS_ROPE); F.hc = (float*)(ws + WS_HC); F.hb = (bf16*)(ws + WS_HB);
    F.Z = (bf16*)(ws + WS_R0); F.XG = (bf16*)(ws + WS_R0); F.U = (bf16*)(ws + WS_U); F.XN = (bf16*)(ws + WS_XN); F.YC = (bf16*)(ws + WS_YC);
    F.hist = (int*)(ws + WS_MOE + MOE_HIST); F.pst = (int*)(ws + WS_MOE + MOE_PST); F.sel = (int*)(ws + WS_MOE + MOE_SEL); F.gates = (f32x2*)(ws + WS_MOE + MOE_GATE); F.slots = (int*)(ws + WS_MOE + MOE_SLOT); F.tok = (int*)(ws + WS_MOE + MOE_TOK);
}

constexpr float SW_GATE = -1.4426950408889634f, SW_UP = -0.6931471805599453f;
__device__ __forceinline__ void p0_transpose_item(const float* W, int K, int N, bf16* WT, int il, LAS float* scr, int item, int lane, const float* kg0 = nullptr, const float* kg1 = nullptr, float wsc = 1.0f    ) {
    const int nblk = N / 32, kb = item / nblk, nb = item % nblk, k0 = 64 * kb, n0 = 32 * nb;
    int orow0 = n0; bool pq = false;
    if (il == 1 || il == 2) orow0 = 256 * (n0 >> 7) + (n0 & 127) + (il == 2 ? 128 : 0);
    if (il == 3 && n0 >= 512 && n0 < 1536) { const int hu = n0 >= 1024, c = (n0 - 512) & 511; orow0 = 512 + 256 * (c >> 7) + 128 * hu + (c & 127); }
    if (il == 3 && n0 >= 1536) {
        if (n0 < 2048) { const int h = (n0 - 1536) >> 6, bj = ((n0 - 1536) >> 5) & 1; orow0 = 1536 + 256 * (h >> 2) + 128 * bj + 32 * (h & 3); pq = true; }
        else if (n0 < 2176) { const int g = (n0 - 2048) >> 6, bj = ((n0 - 2048) >> 5) & 1; orow0 = 2048 + 128 * bj + 32 * g; pq = true; }
        else { const int g = (n0 - 2176) >> 6, dh = ((n0 - 2176) >> 5) & 1; orow0 = 2048 + 64 + 128 * dh + 32 * g; }
    }
    { f32x4 rv[8]; const int kr = lane >> 3, c4 = (lane & 7) * 4;
      const float* wp = W + (size_t)(k0 + kr) * N + n0 + c4;
#pragma unroll
      for (int i = 0; i < 8; ++i) rv[i] = __builtin_nontemporal_load((const f32x4*)(wp + (size_t)(8 * i) * N));
      if (kg0) { const float* kg = (k0 < 512 ? kg0 + k0 : kg1 + (k0 - 512)) + kr;
#pragma unroll
          for (int i = 0; i < 8; ++i) rv[i] = rv[i] * kg[8 * i]; }
      if (wsc != 1.0f) {
#pragma unroll
          for (int i = 0; i < 8; ++i) rv[i] = rv[i] * wsc; }
#pragma unroll
      for (int i = 0; i < 8; ++i) { LAS float* d = scr + (8 * i + kr) * 33 + c4; d[0] = rv[i][0]; d[1] = rv[i][1]; d[2] = rv[i][2]; d[3] = rv[i][3]; } }
    LDS_WAIT(); asm volatile("" ::: "memory");
    const int c = lane & 7;
#pragma unroll
    for (int j = 0; j < 4; ++j) { const int n = (lane >> 3) + 8 * j; const LAS float* s = scr + (8 * c) * 33 + n; const int on = pq ? (8 * ((n >> 2) & 3) + 4 * (n >> 4) + (n & 3)) : n;
        v4u o; o.x = pk2(s[0 * 33], s[1 * 33]); o.y = pk2(s[2 * 33], s[3 * 33]); o.z = pk2(s[4 * 33], s[5 * 33]); o.w = pk2(s[6 * 33], s[7 * 33]);
        *(GAS v4u*)(WT + (size_t)(orow0 + on) * K + k0 + 8 * c) = o; }
    LDS_WAIT(); asm volatile("" ::: "memory");
}
constexpr int I_A = 16 * 72, I_B = 16 * 32, I_C = 16 * 88, I_D = 44 * 32, I_E = 16 * 44, I_F = 22 * 32;
__device__ __forceinline__ void conv_item(CArgs a, LAS float* scr, int lane, int cls, int m, int item) {
    if (cls == 0) { p0_transpose_item(a->in[8] + (size_t)m * 1024 * DIN, 1024, DIN, ((bf16*)(a->ws + WS_WIN)) + (size_t)m * DIN * 1024, 3, scr, item, lane); return; }
    if (cls == 1) { p0_transpose_item(a->in[15] + (size_t)m * 1024 * 1024, 1024, 1024, ((bf16*)(a->ws + WS_WOUT)) + (size_t)m * 1024 * 1024, 0, scr, item, lane, a->in[13] + m * 512, a->in[14] + m * 512); return; }
    if (cls == 2) { const int i = m >> 1, h = m & 1; p0_transpose_item((h ? a->in[17] : a->in[16]) + (size_t)i * 1024 * DFF, 1024, DFF, ((bf16*)(a->ws + WS_W13D)) + (size_t)i * 2 * DFF * 1024, 1 + h, scr, item, lane, nullptr, nullptr, h ? SW_UP : SW_GATE); return; }
    if (cls == 3) { p0_transpose_item(a->in[18] + (size_t)m * DFF * 1024, DFF, 1024, ((bf16*)(a->ws + WS_W2D)) + (size_t)m * 1024 * DFF, 0, scr, item, lane); return; }
    if (cls == 4) { const int ie = m >> 1, h = m & 1; p0_transpose_item((h ? a->in[21] : a->in[20]) + (size_t)ie * 1024 * DFE, 1024, DFE, ((bf16*)(a->ws + WS_W13E)) + (size_t)ie * 2 * DFE * 1024, 1 + h, scr, item, lane, nullptr, nullptr, h ? SW_UP : SW_GATE); return; }
    p0_transpose_item(a->in[22] + (size_t)m * DFE * 1024, DFE, 1024, ((bf16*)(a->ws + WS_W2E)) + (size_t)m * 1024 * DFE, 0, scr, item, lane);
}
constexpr int CONV_N0 = 2 * I_A + 2 * I_B + 2 * I_C + I_D + 16 * I_E + 8 * I_F, CONV_N1 = I_A + I_B + 2 * I_C + I_D, CONV_N2 = I_A + I_B + 16 * I_E + 8 * I_F;
__device__ __forceinline__ void conv_stage_item(CArgs a, LAS float* scr, int lane, int stage, int idx) {
    int r = idx;
    { const int m0 = stage == 0 ? 0 : stage + 1, cnt = stage == 0 ? 2 : 1; if (r < cnt * I_A) { conv_item(a, scr, lane, 0, m0 + r / I_A, r % I_A); return; } r -= cnt * I_A;
      if (r < cnt * I_B) { conv_item(a, scr, lane, 1, m0 + r / I_B, r % I_B); return; } r -= cnt * I_B; }
    if (stage != 2) { const int m0 = stage == 0 ? 0 : 2; if (r < 2 * I_C) { conv_item(a, scr, lane, 2, m0 + r / I_C, r % I_C); return; } r -= 2 * I_C;
        if (r < I_D) { conv_item(a, scr, lane, 3, stage, r); return; } r -= I_D; }
    if (stage != 1) { const int e0 = stage == 0 ? 0 : 16; if (r < 16 * I_E) { conv_item(a, scr, lane, 4, e0 + r / I_E, r % I_E); return; } r -= 16 * I_E;
        conv_item(a, scr, lane, 5, (stage == 0 ? 0 : 8) + r / I_F, r % I_F); }
}
__device__ __forceinline__ void p0_prologue(Frame& F, CArgs a) {
    LAS float* sc = (LAS float*)(F.lds + 73728); LAS float* red = (LAS float*)(F.lds + 73728 + 20480);
    for (int i = F.tid; i < 5120; i += NTHR) { const int r = i >> 10, k = i & 1023; const float x = r < 4 ? a->in[1][r * 1024 + k] : a->in[3][k]; sc[i] = x / (1.0f + expf(-x)); }
    __syncthreads();
    for (int it = F.bid; it < 384; it += F.G) {
        const int L = it / 96, jg = it % 96, col = jg * 64 + F.lane;
        const float* w = a->in[4] + ((size_t)L * 1024 + F.wave * 128) * 6144 + col;
        float a0 = 0.f, a1 = 0.f, a2 = 0.f, a3 = 0.f, a4 = 0.f;
#pragma unroll 8
        for (int kk = 0; kk < 128; ++kk) { const float wv = w[(size_t)kk * 6144]; const int k = F.wave * 128 + kk;
            a0 += sc[k] * wv; a1 += sc[1024 + k] * wv; a2 += sc[2048 + k] * wv; a3 += sc[3072 + k] * wv; a4 += sc[4096 + k] * wv; }
        red[(F.wave * 5 + 0) * 64 + F.lane] = a0; red[(F.wave * 5 + 1) * 64 + F.lane] = a1; red[(F.wave * 5 + 2) * 64 + F.lane] = a2; red[(F.wave * 5 + 3) * 64 + F.lane] = a3; red[(F.wave * 5 + 4) * 64 + F.lane] = a4;
        __syncthreads();
        if (F.wave < 5) { float s = a->in[5][(size_t)L * 6144 + col];
#pragma unroll
            for (int w8 = 0; w8 < 8; ++w8) s += red[(w8 * 5 + F.wave) * 64 + F.lane];
            F.mods[((size_t)L * 5 + F.wave) * 6144 + col] = s; }
        __syncthreads();
    }
    if (F.bid == 0) for (int i = F.tid; i < 2048; i += NTHR) { const int pos = i >> 4, fi = i & 15; const float inv = powf(10000.0f, -(float)fi / 16.0f); const float ang = (float)pos * inv; F.rope[i] = (f32x2){cosf(ang), sinf(ang)}; }
    LAS float* scr = (LAS float*)(F.lds + F.wave * 8704);
    for (int it = F.gw; it < CONV_N0; it += F.NGW) conv_stage_item(a, scr, F.lane, 0, it);
    for (int it = 6592 + 4416 + F.gw; it < CONV_N2; it += F.NGW) conv_stage_item(a, scr, F.lane, 2, it);
}
__device__ __forceinline__ void tail_convert(Frame& F, CArgs a, int stage, int lo, int hi, int first_idle) {
    if (F.bid < first_idle) return;
    LAS float* scr = (LAS float*)(F.lds + F.wave * 8704);
    const int w = (F.bid - first_idle) * NWAVES + F.wave, W = (F.G - first_idle) * NWAVES;
    for (int it = lo + w; it < hi; it += W) conv_stage_item(a, scr, F.lane, stage, it);
}

#define RC(lane, j) (8 * (lane) + 512 * ((j) >> 1) + 4 * ((j) & 1))
__device__ __forceinline__ void row_load(const float* p, int lane, f32x4 (&v)[4]) {
#pragma unroll
    for (int j = 0; j < 4; ++j) v[j] = *(const f32x4*)(p + RC(lane, j));
}
__device__ __forceinline__ void row_store(float* p, int lane, const f32x4 (&v)[4]) {
#pragma unroll
    for (int j = 0; j < 4; ++j) *(f32x4*)(p + RC(lane, j)) = v[j];
}
__device__ __forceinline__ void row_load_raw(const bf16* p, int lane, v4u (&r)[2]) { r[0] = *(const v4u*)(p + 8 * lane); r[1] = *(const v4u*)(p + 8 * lane + 512); }
__device__ __forceinline__ void row_unpack(const v4u (&r)[2], f32x4 (&v)[4]) {
#pragma unroll
    for (int q = 0; q < 2; ++q) { v[2 * q][0] = bflo(r[q].x); v[2 * q][1] = bfhi(r[q].x); v[2 * q][2] = bflo(r[q].y); v[2 * q][3] = bfhi(r[q].y);
        v[2 * q + 1][0] = bflo(r[q].z); v[2 * q + 1][1] = bfhi(r[q].z); v[2 * q + 1][2] = bflo(r[q].w); v[2 * q + 1][3] = bfhi(r[q].w); }
}
__device__ __forceinline__ void row_store_bf16(bf16* p, int lane, const f32x4 (&v)[4]) {
#pragma unroll
    for (int q = 0; q < 2; ++q) { v4u w; w.x = pk2(v[2 * q][0], v[2 * q][1]); w.y = pk2(v[2 * q][2], v[2 * q][3]); w.z = pk2(v[2 * q + 1][0], v[2 * q + 1][1]); w.w = pk2(v[2 * q + 1][2], v[2 * q + 1][3]);
        *(v4u*)(p + 8 * lane + 512 * q) = w; }
}
__device__ __forceinline__ void row_combine(const Frame& F, int row, int mr, int Lprev, int lane, f32x4 (&v)[4]) {
    const int s0 = F.slots[2 * row], s1 = F.slots[2 * row + 1]; const f32x2 g = F.gates[row];
    const bf16* y0 = (const bf16*)F.XG + (size_t)s0 * D; const bf16* y1 = (const bf16*)F.XG + (size_t)s1 * D;
    const float* g2 = F.mods + ((size_t)Lprev * 5 + mr) * 6144 + 5 * 1024;
#pragma unroll
    for (int q = 0; q < 2; ++q) { const int c = 8 * lane + 512 * q; const v4u a = *(const v4u*)(y0 + c), b = *(const v4u*)(y1 + c); const f32x4 gv0 = *(const f32x4*)(g2 + c), gv1 = *(const f32x4*)(g2 + c + 4);
        f32x4 t; t[0] = g.x * bflo(a.x) + g.y * bflo(b.x); t[1] = g.x * bfhi(a.x) + g.y * bfhi(b.x); t[2] = g.x * bflo(a.y) + g.y * bflo(b.y); t[3] = g.x * bfhi(a.y) + g.y * bfhi(b.y);
        v[2 * q] = v[2 * q] + gv0 * t;
        t[0] = g.x * bflo(a.z) + g.y * bflo(b.z); t[1] = g.x * bfhi(a.z) + g.y * bfhi(b.z); t[2] = g.x * bflo(a.w) + g.y * bflo(b.w); t[3] = g.x * bfhi(a.w) + g.y * bfhi(b.w);
        v[2 * q + 1] = v[2 * q + 1] + gv1 * t; }
}
__device__ __forceinline__ void row_add_parts(const float* P, int KS, int crow, const float* gate, int lane, f32x4 (&v)[4]) {
#pragma unroll
    for (int j = 0; j < 4; ++j) { const int c = RC(lane, j); const float* p = P + (size_t)crow * D + c; f32x4 s = *(const f32x4*)p;
        for (int ks = 1; ks < KS; ++ks) s = s + *(const f32x4*)(p + (size_t)ks * 1024 * 1024);
        v[j] = v[j] + *(const f32x4*)(gate + c) * s; }
}
__device__ __forceinline__ void row_norm_mod(const float* gain, const float* shift, const float* scale, int lane, f32x4 (&v)[4]) {
    float s = 0.f;
#pragma unroll
    for (int j = 0; j < 4; ++j) s += (v[j][0] * v[j][0] + v[j][1] * v[j][1]) + (v[j][2] * v[j][2] + v[j][3] * v[j][3]);
    const float rinv = 1.0f / sqrtf(wave_sum(s, lane) * (1.0f / D) + EPS);
#pragma unroll
    for (int j = 0; j < 4; ++j) { const int c = RC(lane, j); const f32x4 gn = *(const f32x4*)(gain + c), sh = *(const f32x4*)(shift + c), sc = *(const f32x4*)(scale + c);
        v[j] = (v[j] * rinv * gn) * (sc + 1.0f) + sh; }
}
struct RowMod { f32x4 G[4], S[4]; int mr; };
__device__ __forceinline__ void rowmod_set(RowMod& M, int mr, const float* gain, const float* shift, const float* scale, int lane) {
    if (mr == M.mr) return;
    M.mr = mr;
#pragma unroll
    for (int j = 0; j < 4; ++j) { const int c = RC(lane, j); const f32x4 gn = *(const f32x4*)(gain + c), sh = *(const f32x4*)(shift + c), sc = *(const f32x4*)(scale + c); M.G[j] = gn * (sc + 1.0f); M.S[j] = sh; }
}
__device__ __forceinline__ void row_norm_apply(const RowMod& M, int lane, f32x4 (&v)[4]) {
    float s = 0.f;
#pragma unroll
    for (int j = 0; j < 4; ++j) s += (v[j][0] * v[j][0] + v[j][1] * v[j][1]) + (v[j][2] * v[j][2] + v[j][3] * v[j][3]);
    const float rinv = 1.0f / sqrtf(wave_sum(s, lane) * (1.0f / D) + EPS);
#pragma unroll
    for (int j = 0; j < 4; ++j) v[j] = (v[j] * rinv) * M.G[j] + M.S[j];
}
__device__ __forceinline__ void row_combine_raw(const v4u (&ya)[2], const v4u (&yb)[2], const f32x2 g, const f32x4 (&g2v)[4], f32x4 (&v)[4]) {
#pragma unroll
    for (int q = 0; q < 2; ++q) { const v4u a = ya[q], b = yb[q]; const f32x4 gv0 = g2v[2 * q], gv1 = g2v[2 * q + 1];
        f32x4 t; t[0] = g.x * bflo(a.x) + g.y * bflo(b.x); t[1] = g.x * bfhi(a.x) + g.y * bfhi(b.x); t[2] = g.x * bflo(a.y) + g.y * bflo(b.y); t[3] = g.x * bfhi(a.y) + g.y * bfhi(b.y);
        v[2 * q] = v[2 * q] + gv0 * t;
        t[0] = g.x * bflo(a.z) + g.y * bflo(b.z); t[1] = g.x * bfhi(a.z) + g.y * bfhi(b.z); t[2] = g.x * bflo(a.w) + g.y * bflo(b.w); t[3] = g.x * bfhi(a.w) + g.y * bfhi(b.w);
        v[2 * q + 1] = v[2 * q + 1] + gv1 * t; }
}
template <bool FIN>
__device__ __forceinline__ void combine_rows(Frame& F, CArgs a, int L, int Lprev) {
    const float* gain = a->in[6] + (size_t)L * D;
    typedef int i32x2 __attribute__((ext_vector_type(2)));
    int row = F.gw; i32x2 sc = {0, 0}, sn = {0, 0}; f32x2 gc = {0.f, 0.f}, gn = {0.f, 0.f}; v4u hr[2], ya[2], yb[2];
    RowMod M; M.mr = -1; f32x4 g2v[4]; int g2mr = -1;
    if (row < ML) { sc = *(const i32x2*)(F.slots + 2 * row); gc = F.gates[row]; }
    if (row + F.NGW < ML) { sn = *(const i32x2*)(F.slots + 2 * (row + F.NGW)); gn = F.gates[row + F.NGW]; }
    if (row < ML) { row_load_raw(F.hb + (size_t)row * D, F.lane, hr); row_load_raw((const bf16*)F.XG + (size_t)sc.x * D, F.lane, ya); row_load_raw((const bf16*)F.XG + (size_t)sc.y * D, F.lane, yb); }
    while (row < ML) {
        f32x4 v[4]; row_unpack(hr, v); const v4u a0 = ya[0], a1 = ya[1], b0 = yb[0], b1 = yb[1]; const f32x2 g = gc;
        const int nrow = row + F.NGW;
        sc = sn; gc = gn;
        if (nrow + F.NGW < ML) { sn = *(const i32x2*)(F.slots + 2 * (nrow + F.NGW)); gn = F.gates[nrow + F.NGW]; }
        if (nrow < ML) { row_load_raw(F.hb + (size_t)nrow * D, F.lane, hr); row_load_raw((const bf16*)F.XG + (size_t)sc.x * D, F.lane, ya); row_load_raw((const bf16*)F.XG + (size_t)sc.y * D, F.lane, yb); }
        const int mr = row >> 13;
        if (mr != g2mr) { g2mr = mr; const float* g2 = F.mods + ((size_t)Lprev * 5 + mr) * 6144 + 5 * 1024;
#pragma unroll
            for (int j = 0; j < 4; ++j) g2v[j] = *(const f32x4*)(g2 + RC(F.lane, j)); }
        { const v4u ca[2] = {a0, a1}, cb[2] = {b0, b1}; row_combine_raw(ca, cb, g, g2v, v); }
        if (FIN) row_store(F.out + (size_t)row * D, F.lane, v);
        else { row_store_bf16(F.hb + (size_t)row * D, F.lane, v);
            const float* md = F.mods + ((size_t)L * 5 + mr) * 6144;
            rowmod_set(M, mr, gain, md, md + 1024, F.lane);
            row_norm_apply(M, F.lane, v);
            row_store_bf16(F.XN + (size_t)row * D, F.lane, v); }
        row = nrow;
    }
}
template <int MODE  >
__device__ __forceinline__ void norm1_rows(Frame& F, CArgs a, int L) {
    const float* gain = a->in[6] + (size_t)L * D;
    RowMod M; M.mr = -1;
    if (MODE == 0) {
        int row = F.gw; f32x4 vn[4];
        if (row < ML) row_load(a->in[0] + (size_t)row * D, F.lane, vn);
        while (row < ML) {
            f32x4 v[4];
#pragma unroll
            for (int j = 0; j < 4; ++j) v[j] = vn[j];
            const int nrow = row + F.NGW;
            if (nrow < ML) row_load(a->in[0] + (size_t)nrow * D, F.lane, vn);
            row_store_bf16(F.hb + (size_t)row * D, F.lane, v);
            const float* md = F.mods + ((size_t)L * 5 + (row >> 13)) * 6144;
            rowmod_set(M, row >> 13, gain, md, md + 1024, F.lane);
            row_norm_apply(M, F.lane, v);
            row_store_bf16(F.XN + (size_t)row * D, F.lane, v);
            row = nrow;
        }
    } else if (MODE == 2) {
        combine_rows<false>(F, a, L, L - 1);
    } else {
        int row = F.gw; v4u rn[2];
        if (row < ML) row_load_raw(F.hb + (size_t)row * D, F.lane, rn);
        while (row < ML) {
            f32x4 v[4]; row_unpack(rn, v);
            const int nrow = row + F.NGW;
            if (nrow < ML) row_load_raw(F.hb + (size_t)nrow * D, F.lane, rn);
            const int mr = row >> 13;
            const float* md = F.mods + ((size_t)L * 5 + mr) * 6144;
            rowmod_set(M, mr, gain, md, md + 1024, F.lane);
            row_norm_apply(M, F.lane, v);
            row_store_bf16(F.XN + (size_t)row * D, F.lane, v);
            row = nrow;
        }
    }
    for (int row = ML + F.gw; row < MT; row += F.NGW) {
        f32x4 v[4]; float* hp = F.hc + (size_t)(row - ML) * D;
        if (MODE == 0) row_load(a->in[2] + (size_t)(row - ML) * D, F.lane, v); else row_load(hp, F.lane, v);
        if (MODE == 2) row_combine(F, row, 4, L - 1, F.lane, v);
        if (MODE == 1) row_add_parts(a->out, 11, row - ML, F.mods + ((size_t)(L - 1) * 5 + 4) * 6144 + 5 * 1024, F.lane, v);
        row_store(hp, F.lane, v);
        const float* md = F.mods + ((size_t)L * 5 + 4) * 6144;
        row_norm_mod(gain, md, md + 1024, F.lane, v);
        row_store_bf16(F.XN + (size_t)row * D, F.lane, v);
    }
}
__device__ __forceinline__ void phase_norm1(Frame& F, CArgs a, int L) {
    if (L == 0) norm1_rows<0>(F, a, L); else if (L == 2) norm1_rows<2>(F, a, L); else norm1_rows<1>(F, a, L);
}
__device__ __forceinline__ void phase_norm2_dense(Frame& F, CArgs a, int L) {
    const float* gain = a->in[7] + (size_t)L * D;
    RowMod M; M.mr = -1;
    int row = F.gw; v4u rn[2];
    if (row < ML) row_load_raw(F.hb + (size_t)row * D, F.lane, rn);
    while (row < ML) {
        f32x4 v[4]; row_unpack(rn, v);
        const int nrow = row + F.NGW;
        if (nrow < ML) row_load_raw(F.hb + (size_t)nrow * D, F.lane, rn);
        const float* md = F.mods + ((size_t)L * 5 + (row >> 13)) * 6144;
        rowmod_set(M, row >> 13, gain, md + 3 * 1024, md + 4 * 1024, F.lane);
        row_norm_apply(M, F.lane, v);
        row_store_bf16(F.XG + (size_t)row * D, F.lane, v);
        row = nrow;
    }
    for (int row = ML + F.gw; row < MT; row += F.NGW) {
        f32x4 v[4]; float* hp = F.hc + (size_t)(row - ML) * D; row_load(hp, F.lane, v);
        const float* md = F.mods + ((size_t)L * 5 + 4) * 6144;
        row_add_parts(a->out, 4, row - ML, md + 2 * 1024, F.lane, v); row_store(hp, F.lane, v);
        row_norm_mod(gain, md + 3 * 1024, md + 4 * 1024, F.lane, v);
        row_store_bf16(F.XG + (size_t)row * D, F.lane, v);
    }
}
__device__ __forceinline__ int moe_row(int bid, int lr, int RPB) { return RPB == 128 ? bid * 128 + lr : (lr < 128 ? bid * 128 + lr : ML + bid * 4 + (lr - 128)); }
__device__ __forceinline__ void phase_norm2_moe(Frame& F, CArgs a, int L) {
    const int nrows = (L == NLAYER - 1) ? ML : MT, RPB = nrows / 256;
    const float* gain = a->in[7] + (size_t)L * D;
    LAS f32x4* rt = (LAS f32x4*)(F.lds);
    LAS int* esel = (LAS int*)(F.lds + 32768);
    const f32x4* rsrc = (const f32x4*)(a->in[19] + (size_t)(L >> 1) * D * NE);
    for (int i = F.tid; i < 2048; i += NTHR) { const int k = i >> 1, hf = i & 1, ln = (k & 511) >> 3, j = 2 * (k >> 9) + ((k >> 2) & 1), ii = k & 3; rt[((j * 4 + ii) * 2 + hf) * 64 + ln] = rsrc[i]; }
    __syncthreads();
    if (F.bid < 256) {
    v4u rn[2]; RowMod M; M.mr = -1;
    row_load_raw(F.hb + (size_t)moe_row(F.bid, F.wave, RPB) * D, F.lane, rn);
    for (int lr = F.wave; lr < RPB; lr += NWAVES) {
        const int row = moe_row(F.bid, lr, RPB); const int mr = row < ML ? (row >> 13) : 4;
        f32x4 v[4];
        if (row < ML) row_unpack(rn, v); else row_load(F.hc + (size_t)(row - ML) * D, F.lane, v);
        if (lr + NWAVES < 128) row_load_raw(F.hb + (size_t)(row + NWAVES) * D, F.lane, rn);
        const float* md = F.mods + ((size_t)L * 5 + mr) * 6144;
        if (row >= ML) { row_add_parts(a->out, 4, row - ML, md + 2 * 1024, F.lane, v); row_store(F.hc + (size_t)(row - ML) * D, F.lane, v); }
        rowmod_set(M, mr, gain, md + 3 * 1024, md + 4 * 1024, F.lane);
        row_norm_apply(M, F.lane, v);
        row_store_bf16(F.XG + (size_t)row * D, F.lane, v);
        float lg0 = 0.f, lg1 = 0.f, lg2 = 0.f, lg3 = 0.f, lg4 = 0.f, lg5 = 0.f, lg6 = 0.f, lg7 = 0.f;
#pragma unroll
        for (int j = 0; j < 4; ++j)
#pragma unroll
            for (int i = 0; i < 4; ++i) { const float x = v[j][i]; const f32x4 r0 = rt[((j * 4 + i) * 2) * 64 + F.lane], r1 = rt[((j * 4 + i) * 2 + 1) * 64 + F.lane];
                lg0 += x * r0[0]; lg1 += x * r0[1]; lg2 += x * r0[2]; lg3 += x * r0[3]; lg4 += x * r1[0]; lg5 += x * r1[1]; lg6 += x * r1[2]; lg7 += x * r1[3]; }
        lg0 = wave_sum(lg0, F.lane); lg1 = wave_sum(lg1, F.lane); lg2 = wave_sum(lg2, F.lane); lg3 = wave_sum(lg3, F.lane); lg4 = wave_sum(lg4, F.lane); lg5 = wave_sum(lg5, F.lane); lg6 = wave_sum(lg6, F.lane); lg7 = wave_sum(lg7, F.lane);
        int e0 = 0; float b0 = lg0;
        if (lg1 > b0) { b0 = lg1; e0 = 1; } if (lg2 > b0) { b0 = lg2; e0 = 2; } if (lg3 > b0) { b0 = lg3; e0 = 3; }
        if (lg4 > b0) { b0 = lg4; e0 = 4; } if (lg5 > b0) { b0 = lg5; e0 = 5; } if (lg6 > b0) { b0 = lg6; e0 = 6; } if (lg7 > b0) { b0 = lg7; e0 = 7; }
        int e1 = -1; float b1 = -INFINITY;
        if (e0 != 0 && lg0 > b1) { b1 = lg0; e1 = 0; } if (e0 != 1 && lg1 > b1) { b1 = lg1; e1 = 1; } if (e0 != 2 && lg2 > b1) { b1 = lg2; e1 = 2; } if (e0 != 3 && lg3 > b1) { b1 = lg3; e1 = 3; }
        if (e0 != 4 && lg4 > b1) { b1 = lg4; e1 = 4; } if (e0 != 5 && lg5 > b1) { b1 = lg5; e1 = 5; } if (e0 != 6 && lg6 > b1) { b1 = lg6; e1 = 6; } if (e0 != 7 && lg7 > b1) { b1 = lg7; e1 = 7; }
        if (e1 < 0) { e1 = (e0 + 1) & 7; b1 = b0; }
        const float t = expf(b1 - b0), g0 = 1.0f / (1.0f + t), g1 = t / (1.0f + t);
        if (F.lane == 0) { const int s = e0 | (e1 << 8); F.sel[row] = s; F.gates[row] = (f32x2){g0, g1}; esel[lr] = s; }
    }
    }
    __syncthreads();
    if (F.tid < 8 && F.bid < 256) { int cnt = 0; for (int lr = 0; lr < RPB; ++lr) { const int s = esel[lr]; cnt += ((s & 255) == F.tid) + ((s >> 8) == F.tid); } F.hist[F.bid * 8 + F.tid] = cnt; }
}
__device__ __forceinline__ void phase_slots(Frame& F, int L) {
    const int nrows = (L == NLAYER - 1) ? ML : MT, RPB = nrows / 256;
    LAS int* hl = (LAS int*)F.lds; LAS int* tot = hl + 2048; LAS int* pre = tot + 8; LAS int* rbase = pre + 8; LAS int* slotl = rbase + 8;
    LAS int* sell = slotl + 2 * 132;
    for (int i = F.tid; i < 2048; i += NTHR) hl[i] = F.hist[i];
    if (F.bid < 256) for (int i = F.tid; i < RPB; i += NTHR) sell[i] = F.sel[moe_row(F.bid, i, RPB)];
    __syncthreads();
    if (F.tid < 8) { int t = 0, p = 0; for (int b = 0; b < 256; ++b) { const int h = hl[b * 8 + F.tid]; if (b < F.bid) p += h; t += h; } tot[F.tid] = t; pre[F.tid] = p; }
    __syncthreads();
    if (F.tid == 0) { int ps = 0; for (int e = 0; e < 8; ++e) { rbase[e] = ps * 256 + pre[e]; if (F.bid == 0) F.pst[e] = ps; ps += (tot[e] + 255) >> 8; } if (F.bid == 0) F.pst[8] = ps; }
    __syncthreads();
    if (F.bid < 256) {
    if (F.tid < 8) { int off = rbase[F.tid]; for (int lr = 0; lr < RPB; ++lr) { const int s = sell[lr]; if ((s & 255) == F.tid) slotl[2 * lr] = off++; if ((s >> 8) == F.tid) slotl[2 * lr + 1] = off++; } }
    }
    __syncthreads();
    if (F.bid < 256) {
    for (int lr = F.tid; lr < RPB; lr += NTHR) { const int row = moe_row(F.bid, lr, RPB); const int s0 = slotl[2 * lr], s1 = slotl[2 * lr + 1];
        F.slots[2 * row] = s0; F.slots[2 * row + 1] = s1; F.tok[s0] = row; F.tok[s1] = row; }
    }
    if (F.bid == 0 && F.tid < 8) { const int e = F.tid; int ps = 0; for (int q = 0; q < e; ++q) ps += (tot[q] + 255) >> 8;
        const int s1 = (ps + ((tot[e] + 255) >> 8)) * 256; int z = 0; asm volatile("" : "+v"(z));
        for (int s = ps * 256 + tot[e]; s < s1; ++s) F.tok[s] = z; }
}
__device__ __forceinline__ void unpack8(const v4u w, float (&f)[8]) { f[0] = bflo(w.x); f[1] = bfhi(w.x); f[2] = bflo(w.y); f[3] = bfhi(w.y); f[4] = bflo(w.z); f[5] = bfhi(w.z); f[6] = bflo(w.w); f[7] = bfhi(w.w); }
__device__ __forceinline__ void phase_convnorm(Frame& F, CArgs a, int L, int gw, int ngw) {
    const int nrows = (L == NLAYER - 1) ? ML : MT; const int c8 = F.lane * 8;
    const float* cw = a->in[9] + (size_t)L * 3 * 512;
    float w0[8], w1[8], w2[8];
#pragma unroll
    for (int i = 0; i < 8; ++i) { w0[i] = cw[c8 + i]; w1[i] = cw[512 + c8 + i]; w2[i] = cw[1024 + c8 + i]; }
    const int RPW = (nrows + ngw - 1) / ngw; int row = gw * RPW; const int rend = (row + RPW < nrows) ? row + RPW : nrows;
    if (row >= rend) return;
    const int rmax = nrows - 1;
#define CONV_U(r) (*(const v4u*)(F.Z + (size_t)((r) < 0 ? 0 : ((r) > rmax ? rmax : (r))) * DIN + 512 + c8))
#define CONV_BG(r) (*(const v4u*)(F.Z + (size_t)((r) > rmax ? rmax : (r)) * DIN + c8))
    v4u up = CONV_U(row - 1), uc = CONV_U(row), un = CONV_U(row + 1), bgc = CONV_BG(row);
    for (; row < rend; ++row) {
        const v4u un2 = CONV_U(row + 2), bgn = CONV_BG(row + 1);
        const bool lat = row < ML; const int tt = lat ? (row & (SEQ - 1)) : ((row - ML) & (CTXL - 1)); const int tlen = lat ? SEQ : CTXL;
        float bg[8], uu[8], y[8];
        unpack8(bgc, bg); unpack8(uc, uu);
#pragma unroll
        for (int i = 0; i < 8; ++i) y[i] = w1[i] * uu[i];
        if (tt > 0) { unpack8(up, uu);
#pragma unroll
            for (int i = 0; i < 8; ++i) y[i] += w0[i] * uu[i]; }
        if (tt < tlen - 1) { unpack8(un, uu);
#pragma unroll
            for (int i = 0; i < 8; ++i) y[i] += w2[i] * uu[i]; }
        float s = 0.f;
#pragma unroll
        for (int i = 0; i < 8; ++i) { y[i] *= bg[i]; s += y[i] * y[i]; }
        const float rinv = 1.0f / sqrtf(wave_sum(s, F.lane) * (1.0f / 512.0f) + EPS);
        v4u o; o.x = pk2(y[0] * rinv, y[1] * rinv); o.y = pk2(y[2] * rinv, y[3] * rinv); o.z = pk2(y[4] * rinv, y[5] * rinv); o.w = pk2(y[6] * rinv, y[7] * rinv);
        *(v4u*)(F.YC + (size_t)row * D + c8) = o;
        up = uc; uc = un; un = un2; bgc = bgn;
    }
#undef CONV_U
#undef CONV_BG
}
__device__ __forceinline__ void phase_final(Frame& F, CArgs a) { combine_rows<true>(F, a, 0, NLAYER - 1); }
namespace att {
typedef short s16x4 __attribute__((ext_vector_type(4)));
typedef float f32x16 __attribute__((ext_vector_type(16)));
constexpr int TILE_B = 32768, GRP_B = 16384, L_K = 0, L_V = 8192, L_SS = 2 * TILE_B, L_OST = L_SS + 1024, L_END = L_OST + 8 * 4096;
static_assert(L_END <= RING_BYTES, "attention LDS map");
__device__ __forceinline__ int crow(int r, int hi) { return (r & 3) + 8 * (r >> 2) + 4 * hi; }
__device__ __forceinline__ void pv(f32x16* o, int vb, bf16x8 pa0, bf16x8 pa1, bf16x8 pa2, bf16x8 pa3) {
    s16x4 lo[8], hi[8];
#pragma unroll
    for (int d0 = 0; d0 < 2; ++d0)
#pragma unroll
        for (int ks = 0; ks < 4; ++ks) {
            asm volatile("ds_read_b64_tr_b16 %0,%1 offset:%c2" : "=&v"(lo[d0 * 4 + ks]) : "v"(vb), "i"(d0 * 4096 + ks * 1024) : "memory");
            asm volatile("ds_read_b64_tr_b16 %0,%1 offset:%c2" : "=&v"(hi[d0 * 4 + ks]) : "v"(vb), "i"(d0 * 4096 + ks * 1024 + 512) : "memory"); }
    asm volatile("s_waitcnt lgkmcnt(0)" ::: "memory"); __builtin_amdgcn_sched_barrier(0);
#define PK(k) (bf16x8){lo[k][0], lo[k][1], lo[k][2], lo[k][3], hi[k][0], hi[k][1], hi[k][2], hi[k][3]}
    o[0] = __builtin_amdgcn_mfma_f32_32x32x16_bf16(PK(0), pa0, o[0], 0, 0, 0); o[1] = __builtin_amdgcn_mfma_f32_32x32x16_bf16(PK(4), pa0, o[1], 0, 0, 0);
    o[0] = __builtin_amdgcn_mfma_f32_32x32x16_bf16(PK(1), pa1, o[0], 0, 0, 0); o[1] = __builtin_amdgcn_mfma_f32_32x32x16_bf16(PK(5), pa1, o[1], 0, 0, 0);
    o[0] = __builtin_amdgcn_mfma_f32_32x32x16_bf16(PK(2), pa2, o[0], 0, 0, 0); o[1] = __builtin_amdgcn_mfma_f32_32x32x16_bf16(PK(6), pa2, o[1], 0, 0, 0);
    o[0] = __builtin_amdgcn_mfma_f32_32x32x16_bf16(PK(3), pa3, o[0], 0, 0, 0); o[1] = __builtin_amdgcn_mfma_f32_32x32x16_bf16(PK(7), pa3, o[1], 0, 0, 0);
#undef PK
}
__device__ __forceinline__ void softmax_tile(f32x16& p0, f32x16& p1, float& l, bool masked, int kq0  , int hi) {
    if (masked) { int nb_ = (int)0xff800000u; asm volatile("" : "+s"(nb_)); const float ninf = __int_as_float(nb_);
#pragma unroll
        for (int r = 0; r < 16; ++r) { const int d0 = kq0 + crow(r, hi), d1 = d0 + 32;
            if (d0 > 128 || d0 < -128) p0[r] = ninf;
            if (d1 > 128 || d1 < -128) p1[r] = ninf; }
    }
    float s0 = 0.f, s1 = 0.f, s2 = 0.f, s3 = 0.f;
#pragma unroll
    for (int r = 0; r < 16; r += 2) { p0[r] = __builtin_amdgcn_exp2f(p0[r]); p0[r + 1] = __builtin_amdgcn_exp2f(p0[r + 1]); p1[r] = __builtin_amdgcn_exp2f(p1[r]); p1[r + 1] = __builtin_amdgcn_exp2f(p1[r + 1]);
        s0 += p0[r]; s1 += p0[r + 1]; s2 += p1[r]; s3 += p1[r + 1]; }
    l += (s0 + s1) + (s2 + s3);
}
#define ATT_PACK(pw, p0, p1) do { pw[0] = (v4u){pk2(p0[0], p0[1]), pk2(p0[2], p0[3]), pk2(p0[4], p0[5]), pk2(p0[6], p0[7])}; pw[1] = (v4u){pk2(p0[8], p0[9]), pk2(p0[10], p0[11]), pk2(p0[12], p0[13]), pk2(p0[14], p0[15])}; \
        pw[2] = (v4u){pk2(p1[0], p1[1]), pk2(p1[2], p1[3]), pk2(p1[4], p1[5]), pk2(p1[6], p1[7])}; pw[3] = (v4u){pk2(p1[8], p1[9]), pk2(p1[10], p1[11]), pk2(p1[12], p1[13]), pk2(p1[14], p1[15])}; } while (0)
__device__ __forceinline__ void unit8(LAS unsigned char* lds, const bf16* Z, bf16* YC, const float* sinkp, int b, int qrow0, int qpos0, int lane, int wid) {
    const int r32 = lane & 31, hi = lane >> 5, g = wid >> 2, hq = 4 * g + 2 * ((wid >> 1) & 1), pr = wid & 1;
    int seqm1 = SEQ - 1; asm volatile("" : "+s"(seqm1));
    int tw0 = 0, nwin = 0;
    if (qpos0 >= 0) { tw0 = (128 - qpos0) > 0 ? (128 - qpos0 + 63) / 64 : 0; int tw1 = (SEQ - 1 + 128 - qpos0) / 64; if (tw1 > 4) tw1 = 4; nwin = tw1 - tw0 + 1; }
    const int NT = nwin + 4;
    const bf16* kbase = Z + 2048 + 128 * (wid >> 2) + 8 * (wid & 3);
    const bf16* vbase = Z + 2048 + 64 + 128 * (wid >> 2) + (lane & 3) * 8;
#define ATT_DMA(i, buf) do { int krow_, vrow_; if ((i) < nwin) { const int kp0_ = qpos0 - 128 + 64 * (tw0 + (i)); int kp_ = kp0_ + lane; kp_ = kp_ < 0 ? 0 : (kp_ > seqm1 ? seqm1 : kp_); krow_ = b * SEQ + kp_; \
        int vp_ = kp0_ + 16 * (wid & 3) + (lane >> 2); vp_ = vp_ < 0 ? 0 : (vp_ > seqm1 ? seqm1 : vp_); vrow_ = b * SEQ + vp_; } \
        else { const int j_ = (i) - nwin; krow_ = ML + b * CTXL + 64 * j_ + lane; vrow_ = ML + b * CTXL + 64 * j_ + 16 * (wid & 3) + (lane >> 2); } \
        const bf16* kp__ = kbase + (size_t)krow_ * DIN; const bf16* vp__ = vbase + (size_t)vrow_ * DIN; LAS unsigned char* d_ = lds + (buf) * TILE_B + wid * 1024; \
        __builtin_amdgcn_global_load_lds((const unsigned*)kp__, (LAS unsigned*)(d_ + L_K), 16, 0, 0); __builtin_amdgcn_global_load_lds((const unsigned*)(kp__ + 32), (LAS unsigned*)(d_ + GRP_B + L_K), 16, 0, 0); \
        __builtin_amdgcn_global_load_lds((const unsigned*)vp__, (LAS unsigned*)(d_ + L_V), 16, 0, 0); __builtin_amdgcn_global_load_lds((const unsigned*)(vp__ + 32), (LAS unsigned*)(d_ + GRP_B + L_V), 16, 0, 0); } while (0)
    ATT_DMA(0, 0); ATT_DMA(1, 1);
    bf16x8 qr[2][4];
#pragma unroll
    for (int hh = 0; hh < 2; ++hh) { const bf16* Qw = Z + (size_t)(qrow0 + 32 * pr + r32) * DIN + 1536 + 256 * g + 32 * ((hq + hh) & 3) + hi * 8;
#pragma unroll
        for (int d0 = 0; d0 < 4; ++d0) qr[hh][d0] = *(const bf16x8*)(Qw + 128 * (d0 >> 1) + 16 * (d0 & 1)); }
    float l[2]; f32x16 o[2][2];
#pragma unroll
    for (int hh = 0; hh < 2; ++hh) { l[hh] = (hi == 0) ? __builtin_amdgcn_exp2f(sinkp[hq + hh] * LOG2E) : 0.0f; o[hh][0] = f32x16{}; o[hh][1] = f32x16{}; }
    const int vb0 = (int)(unsigned)(uintptr_t)(lds + g * GRP_B + L_V) + ((lane >> 4) & 1) * 32 + (lane & 3) * 8 + (4 * hi + ((lane & 15) >> 2)) * 64;
    const LAS unsigned char* kb0 = lds + g * GRP_B + L_K + hi * 1024 + r32 * 16;
    asm volatile("s_waitcnt vmcnt(0)" ::: "memory");
    __syncthreads();
#pragma nounroll
    for (int i = 0; i < NT; ++i) {
        const int bo = (i & 1) * TILE_B;
        bool need = true, masked = false; int kq0 = 0;
        if (i < nwin) { const int k0 = -128 + 64 * (tw0 + i), r0 = 32 * pr; need = (k0 + 63 >= r0 - 128) && (k0 <= r0 + 31 + 128); masked = !((k0 >= r0 + 31 - 128) && (k0 + 63 <= r0 + 128)); kq0 = k0 - r0 - r32; }
        if (need) {
            v4u pw[2][4];
            { bf16x8 kf[8];
#pragma unroll
              for (int d0 = 0; d0 < 4; ++d0) { kf[2 * d0] = *(const LAS bf16x8*)(kb0 + bo + d0 * 2048); kf[2 * d0 + 1] = *(const LAS bf16x8*)(kb0 + bo + d0 * 2048 + 512); }
#pragma unroll
              for (int hh = 0; hh < 2; ++hh) { f32x16 p0 = f32x16{}, p1 = f32x16{};
                  __builtin_amdgcn_s_setprio(1);
#pragma unroll
                  for (int d0 = 0; d0 < 4; ++d0) { p0 = __builtin_amdgcn_mfma_f32_32x32x16_bf16(kf[2 * d0], qr[hh][d0], p0, 0, 0, 0); p1 = __builtin_amdgcn_mfma_f32_32x32x16_bf16(kf[2 * d0 + 1], qr[hh][d0], p1, 0, 0, 0); }
                  __builtin_amdgcn_s_setprio(0);
                  softmax_tile(p0, p1, l[hh], masked, kq0, hi);
                  ATT_PACK(pw[hh], p0, p1); } }
            { s16x4 vlo[8], vhi[8]; const int vb = vb0 + bo;
#pragma unroll
              for (int d0 = 0; d0 < 2; ++d0)
#pragma unroll
                  for (int ks = 0; ks < 4; ++ks) {
                      asm volatile("ds_read_b64_tr_b16 %0,%1 offset:%c2" : "=&v"(vlo[d0 * 4 + ks]) : "v"(vb), "i"(d0 * 4096 + ks * 1024) : "memory");
                      asm volatile("ds_read_b64_tr_b16 %0,%1 offset:%c2" : "=&v"(vhi[d0 * 4 + ks]) : "v"(vb), "i"(d0 * 4096 + ks * 1024 + 512) : "memory"); }
              asm volatile("s_waitcnt lgkmcnt(0)" ::: "memory"); __builtin_amdgcn_sched_barrier(0);
              __builtin_amdgcn_s_setprio(1);
#define PK(k) (bf16x8){vlo[k][0], vlo[k][1], vlo[k][2], vlo[k][3], vhi[k][0], vhi[k][1], vhi[k][2], vhi[k][3]}
#pragma unroll
              for (int ks = 0; ks < 4; ++ks)
#pragma unroll
                  for (int hh = 0; hh < 2; ++hh) { o[hh][0] = __builtin_amdgcn_mfma_f32_32x32x16_bf16(PK(ks), __builtin_bit_cast(bf16x8, pw[hh][ks]), o[hh][0], 0, 0, 0);
                      o[hh][1] = __builtin_amdgcn_mfma_f32_32x32x16_bf16(PK(4 + ks), __builtin_bit_cast(bf16x8, pw[hh][ks]), o[hh][1], 0, 0, 0); }
              __builtin_amdgcn_s_setprio(0);
#undef PK
            }
        }
        asm volatile("s_waitcnt vmcnt(0)" ::: "memory");
        __syncthreads();
        if (i + 2 < NT) ATT_DMA(i + 2, i & 1);
    }
#undef ATT_DMA
    LAS float* ss = (LAS float*)(lds + L_SS);
    float rl[2], sq = 0.f;
#pragma unroll
    for (int hh = 0; hh < 2; ++hh) { float lt = l[hh]; lt += shx(lt, 32, lane); rl[hh] = 1.0f / lt; float s = 0.f;
#pragma unroll
        for (int d0 = 0; d0 < 2; ++d0)
#pragma unroll
            for (int r = 0; r < 16; ++r) { const float t = o[hh][d0][r] * rl[hh]; s += t * t; }
        sq += s; }
    sq += shx(sq, 32, lane);
    if (hi == 0) ss[(32 * pr + r32) * 4 + (wid >> 1)] = sq;
    __syncthreads();
    float rinv; { const f32x4 t = *(const LAS f32x4*)(ss + (32 * pr + r32) * 4); rinv = 1.0f / sqrtf(((t[0] + t[1]) + (t[2] + t[3])) * (1.0f / 512.0f) + EPS); }
    LAS bf16* stg = (LAS bf16*)(lds + L_OST) + wid * 2048;
#pragma unroll
    for (int hh = 0; hh < 2; ++hh) {
        const float sc = rl[hh] * rinv;
#pragma unroll
        for (int d0 = 0; d0 < 2; ++d0)
#pragma unroll
            for (int gq = 0; gq < 4; ++gq) { v2u w; w.x = pk2(o[hh][d0][4 * gq] * sc, o[hh][d0][4 * gq + 1] * sc); w.y = pk2(o[hh][d0][4 * gq + 2] * sc, o[hh][d0][4 * gq + 3] * sc);
                *(LAS v2u*)(stg + r32 * 64 + 32 * d0 + 8 * gq + 4 * hi) = w; }
        asm volatile("s_waitcnt lgkmcnt(0)" ::: "memory");
        bf16* Ow = YC + (size_t)(qrow0 + 32 * pr) * D + 512 + (hq + hh) * 64;
#pragma unroll
        for (int i = 0; i < 4; ++i) { const int row = i * 8 + (lane >> 3), ch = lane & 7; const v4u v = *(const LAS v4u*)(stg + row * 64 + ch * 8); *(v4u*)(Ow + (size_t)row * D + ch * 8) = v; }
        asm volatile("s_waitcnt lgkmcnt(0)" ::: "memory");
    }
}
}
__device__ __forceinline__ void phase_attn(Frame& F, CArgs a, int L) {
    const float* sinkp = a->in[12] + L * 8;
    for (int u = F.bid; u < 512; u += F.G) { const int b = u >> 7, qb = u & 127;
        att::unit8(F.lds, F.Z, F.YC, sinkp, b, b * SEQ + qb * 64, qb * 64, F.lane, F.wave); }
    const bool ctxu = (L != NLAYER - 1);
    if (ctxu && F.bid < 16) { const int b = F.bid >> 2, qb = F.bid & 3; att::unit8(F.lds, F.Z, F.YC, sinkp, b, ML + b * CTXL + qb * 64, -1, F.lane, F.wave); return; }
    const int nb0 = ctxu ? 16 : 0;
    phase_convnorm(F, a, L, (F.bid - nb0) * NWAVES + F.wave, (F.G - nb0) * NWAVES);
}
constexpr int NPH = 42;
__global__ void __launch_bounds__(NTHR, 2) fwd(Args args_unused) {
    extern __shared__ __attribute__((aligned(16))) unsigned char lds[];
    for (int u = threadIdx.x; u < (LDS_BYTES - LDSCTL_OFF) / 4; u += NTHR) ((LAS unsigned*)((LAS unsigned char*)lds + LDSCTL_OFF))[u] = 0u;
    __syncthreads();
    int lo, hi; { CArgs a0 = get_args(); lo = a0->ph_lo; hi = a0->ph_hi; }
    if (hi - lo > 1) { CArgs a0 = get_args(); (void)xcd_barrier_post((unsigned*)(a0->ws + WS_CTL) + 4096, (volatile LAS unsigned*)((LAS unsigned char*)lds + MISC_OFF) + 8); }
#define FRAME() Frame F; { int t_ = threadIdx.x, b_ = blockIdx.x, g_ = gridDim.x; asm volatile("" : "+v"(t_)); asm volatile("" : "+s"(b_), "+s"(g_)); \
        F.lds = (LAS unsigned char*)lds; F.tid = t_; F.lane = t_ & 63; F.wave = __builtin_amdgcn_readfirstlane(t_ >> 6); F.G = g_; F.bid = b_; F.gw = b_ * NWAVES + F.wave; F.NGW = g_ * NWAVES; }
#define IN(k) (lo <= (k) && (k) < hi)
#define SEAM(k) do { if ((k) + 1 < hi) { CArgs a_ = get_args(); XcdBarrier b_; b_.bar = (unsigned*)(a_->ws + WS_CTL) + 4096; b_.x = xb_xcc_id(); b_.st = (volatile LAS unsigned*)((LAS unsigned char*)lds + MISC_OFF) + 8; xcd_barrier(b_); } } while (0)
    if (IN(0)) { FRAME(); CArgs ap = get_args(); bind(F, ap); p0_prologue(F, ap); SEAM(0); }
    for (int L = 0; L < NLAYER; ++L) {
        const int pb = 1 + 10 * L; const bool last = (L == NLAYER - 1), moe = (L & 1) != 0;
        if (IN(pb + 0)) { FRAME(); CArgs ap = get_args(); bind(F, ap); phase_norm1(F, ap, L); SEAM(pb + 0); }
        if (IN(pb + 1)) {
            FRAME(); CArgs ap = get_args(); unsigned char* ws = ap->ws;
            pg8::Gemm g{(const bf16*)(ws + WS_XN), (const bf16*)(ws + WS_WIN) + (size_t)L * DIN * 1024, 1024, 1024, nullptr}; pg8::Sched S; S.init(MT / 256, DIN / 256, F.G, F.bid);
            pg8::EpiIn E{(bf16*)(ws + WS_R0), ap->in[10] + L * 64, ap->in[11] + L * 64, (const float*)(ws + WS_ROPE), QSCALE, EPS};
            pg8::gemm_phase<pg8::EpiIn, pg8::Sched, true, true>(F.lds + RING_OFF, g, S, E);
            { constexpr int FI = (MT / 256 * (DIN / 256)) % 256, Q = (256 - FI) * NWAVES * 6;
              if (L <= 1) { FRAME(); CArgs ap2 = get_args();
                  if (L == 0) tail_convert(F, ap2, 1, 0, Q, FI);
                  else tail_convert(F, ap2, 2, 6592, 6592 + Q, FI); } }
            SEAM(pb + 1);
        }
        if (IN(pb + 3)) { FRAME(); CArgs ap = get_args(); bind(F, ap); phase_attn(F, ap, L); SEAM(pb + 3); }
        if (IN(pb + 5)) {
            FRAME(); CArgs ap = get_args(); unsigned char* ws = ap->ws;
            { pg8::Gemm g{(const bf16*)(ws + WS_YC), (const bf16*)(ws + WS_WOUT) + (size_t)L * 1024 * 1024, 1024, 1024, nullptr}; pg8::Sched S; S.init(ML / 256, 4, F.G, F.bid);
              pg8::EpiRes<0> E{(bf16*)(ws + WS_HB), (const float*)(ws + WS_MODS) + (size_t)L * 5 * 6144 + 2 * 1024, nullptr, 4};
              pg8::gemm_phase<pg8::EpiRes<0>, pg8::Sched, true, true>(F.lds + RING_OFF, g, S, E); }
            if (!last) {
                pg8::Gemm g{(const bf16*)(ws + WS_YC), (const bf16*)(ws + WS_WOUT) + (size_t)L * 1024 * 1024, 256, 1024, nullptr}; pg8::Sched S; S.init(4, 4, F.G, F.bid); S.split = 4; S.nwg = 64; S.kp2 = 512;
                pg8::EpiPart E{ap->out};
                pg8::gemm_phase<pg8::EpiPart, pg8::Sched, true, true>(F.lds + RING_OFF, g, S, E); }
            SEAM(pb + 5);
        }
        if (IN(pb + 6)) { FRAME(); CArgs ap = get_args(); bind(F, ap); if (moe) phase_norm2_moe(F, ap, L); else phase_norm2_dense(F, ap, L); SEAM(pb + 6); }
        if (moe && IN(pb + 7)) { FRAME(); CArgs ap = get_args(); bind(F, ap); phase_slots(F, L); SEAM(pb + 7); }
        if (IN(pb + 8)) {
            FRAME(); CArgs ap = get_args(); unsigned char* ws = ap->ws;
            if (!moe) {
                pg8::Gemm g{(const bf16*)(ws + WS_R0), (const bf16*)(ws + WS_W13D) + (size_t)(L >> 1) * 2 * DFF * 1024, 1024, 1024, nullptr};
                pg8::Sched S; S.init(MT / 256, 22, F.G, F.bid);
                pg8::EpiSwiGLU E{(bf16*)(ws + WS_U), DFF, 22};
                pg8::gemm_phase<pg8::EpiSwiGLU, pg8::Sched, true, true>(F.lds + RING_OFF, g, S, E);
                { constexpr int FI = (MT / 256 * 22) % 256;
                  if (L == 0) { FRAME(); CArgs ap2 = get_args(); tail_convert(F, ap2, 1, 4416, CONV_N1, FI); tail_convert(F, ap2, 2, 0, 6592, FI); } }
            } else {
                const int* pst = (const int*)(ws + WS_MOE + MOE_PST);
                pg8::Gemm g{(const bf16*)(ws + WS_R0), (const bf16*)(ws + WS_W13E) + (size_t)(L >> 1) * 8 * 2 * DFE * 1024, 1024, 1024, (const int*)(ws + WS_MOE + MOE_TOK)};
                pg8::Sched S; S.init(pst[8], 11, F.G, F.bid); S.moe = 1;
#pragma unroll
                for (int j = 0; j < 8; ++j) S.ps[j] = pst[j];
                pg8::EpiSwiGLU E{(bf16*)(ws + WS_U), DFE, 11};
                pg8::gemm_phase<pg8::EpiSwiGLU, pg8::Sched, true, true, true>(F.lds + RING_OFF, g, S, E);
            }
            SEAM(pb + 8);
        }
        if (IN(pb + 9)) {
            FRAME(); CArgs ap = get_args(); unsigned char* ws = ap->ws;
            if (!moe) {
                pg8::Gemm g{(const bf16*)(ws + WS_U), (const bf16*)(ws + WS_W2D) + (size_t)(L >> 1) * 1024 * DFF, DFF, DFF, nullptr};
                pg8::Sched S; S.init(ML / 256, 4, F.G, F.bid);
                pg8::EpiRes<0> E{(bf16*)(ws + WS_HB), (const float*)(ws + WS_MODS) + (size_t)L * 5 * 6144 + 5 * 1024, nullptr, 4};
                pg8::gemm_phase<pg8::EpiRes<0>, pg8::Sched, true, true>(F.lds + RING_OFF, g, S, E);
                { pg8::Gemm g2{(const bf16*)(ws + WS_U), (const bf16*)(ws + WS_W2D) + (size_t)(L >> 1) * 1024 * DFF, 256, DFF, nullptr}; pg8::Sched S2; S2.init(4, 4, F.G, F.bid); S2.split = 11; S2.nwg = 176; S2.kp2 = 512;
                  pg8::EpiPart E2{ap->out};
                  pg8::gemm_phase<pg8::EpiPart, pg8::Sched, true, true>(F.lds + RING_OFF, g2, S2, E2); }
            } else {
                const int* pst = (const int*)(ws + WS_MOE + MOE_PST);
                pg8::Gemm g{(const bf16*)(ws + WS_U), (const bf16*)(ws + WS_W2E) + (size_t)(L >> 1) * 8 * 1024 * DFE, DFE, DFE, nullptr};
                const int nfull = (pst[8] * 4) / 256 * 256, ntail = pst[8] * 4 - nfull;
                { pg8::Sched S; S.init(pst[8], 4, F.G, F.bid); S.moe = 1; if (ntail * 4 <= 256) S.nwg = nfull;
#pragma unroll
                  for (int j = 0; j < 8; ++j) S.ps[j] = pst[j];
                  pg8::EpiRes<1> E{nullptr, nullptr, (bf16*)(ws + WS_R0), 4};
                  pg8::gemm_phase<pg8::EpiRes<1>, pg8::Sched, true, true>(F.lds + RING_OFF, g, S, E); }
                if (ntail > 0 && ntail * 4 <= 256) { pg8::SchedT T; T.init(pst[8], 4, F.G, F.bid); T.moe = 1; T.nfull = nfull; T.npiece = ntail * 4; T.tsplit = 4;
#pragma unroll
                  for (int j = 0; j < 8; ++j) T.ps[j] = pst[j];
                  pg8::EpiRes<2> E2{nullptr, nullptr, (bf16*)(ws + WS_R0), 4};
                  pg8::gemm_phase<pg8::EpiRes<2>, pg8::SchedT, true, true>(F.lds + RING_OFF, g, T, E2); }
            }
            SEAM(pb + 9);
        }
    }
    if (IN(NPH - 1)) { FRAME(); CArgs ap = get_args(); bind(F, ap); phase_final(F, ap); }
#undef IN
#undef SEAM
}

extern "C" void kernel_launch(void* const* d_in, const int* in_sizes, int n_in, void* d_out, int out_size, void* d_ws, size_t ws_size, hipStream_t stream) {
    static int ready = 0;
    if (ready == 0) {
        if (n_in != 23 || out_size != ML * D || ws_size < WS_END) { fprintf(stderr, "kernel_launch: unexpected shapes (n_in %d, out %d, ws %zu)\n", n_in, out_size, ws_size); ready = -1; return; }
        if (hipFuncSetAttribute((const void*)fwd, hipFuncAttributeMaxDynamicSharedMemorySize, LDS_BYTES) != hipSuccess) { fprintf(stderr, "kernel_launch: hipFuncSetAttribute failed\n"); ready = -1; return; }
        ready = 1;
    }
    if (ready < 0) return;
    (void)hipMemsetAsync((char*)d_ws + WS_CTL, 0, CTL_ZERO_BYTES, stream);
#ifdef DBG_POISON
    (void)hipMemsetAsync((char*)d_ws + MiB, 0xFF, WS_END - MiB, stream);
    (void)hipMemsetAsync(d_out, 0xFF, (size_t)ML * D * 4, stream);
#endif
    Args a{};
    for (int i = 0; i < 23; ++i) a.in[i] = (const float*)d_in[i];
    a.out = (float*)d_out; a.ws = (unsigned char*)d_ws;
#if MK_SINGLE
    a.ph_lo = 0; a.ph_hi = NPH;
    hipLaunchKernelGGL(fwd, dim3(256), dim3(NTHR), LDS_BYTES, stream, a);
#else
#ifndef DBG_MAXPH
#define DBG_MAXPH NPH
#endif
    for (int p = 0; p < DBG_MAXPH; ++p) {
        if (p >= 1 && p < NPH - 1) { const int L = (p - 1) / 10, q = (p - 1) % 10; if ((q == 7 && !(L & 1)) || q == 2 || q == 4) continue; }
        a.ph_lo = p; a.ph_hi = p + 1;
        hipLaunchKernelGGL(fwd, dim3(256), dim3(NTHR), LDS_BYTES, stream, a);
    }
#endif
}
```
